# Optimizing an MI355X kernel written in HIP

```python
import jax, jax.numpy as jnp
from jax import lax
import numpy as np

D_MODEL = 1024
BATCH = 8
SEQ = 4096
DEPTH = 4

N_META = 16
D_MIX = D_MODEL
D_CONV = D_MIX // 2
CONV_WIDTH = 31
N_HEADS = 8
HEAD_DIM = 64
D_ATTN = N_HEADS * HEAD_DIM
N_IDX_HEADS = 8
IDX_DIM = 64
TOPK_MAX = 256
ROPE_THETA = 10000.0
Q_BLOCK = 64
POS_BLOCK = 128
LN_EPS = 1e-5
IDX_SCALE = IDX_DIM ** -0.5
IDX_W_SCALE = N_IDX_HEADS ** -0.5
DEEPNORM_ALPHA = (2.0 * DEPTH) ** 0.25
DEEPNORM_BETA = (8.0 * DEPTH) ** -0.25

IN_SIZES = [D_CONV, D_CONV, D_CONV, D_ATTN, D_ATTN, D_ATTN, D_ATTN,
            N_IDX_HEADS * IDX_DIM, IDX_DIM, N_IDX_HEADS]
D_IN = sum(IN_SIZES)
IN_SPLITS = [sum(IN_SIZES[:i + 1]) for i in range(len(IN_SIZES) - 1)]

kernel_name = "hymba_conformer_dsa_deepnorm"


def layer_norm(x, g, b):
    xf = x.astype(jnp.float32)
    mu = jnp.mean(xf, axis=-1, keepdims=True)
    var = jnp.mean(jnp.square(xf - mu), axis=-1, keepdims=True)
    y = (xf - mu) * lax.rsqrt(var + LN_EPS) * g.astype(jnp.float32) + b.astype(jnp.float32)
    return y.astype(x.dtype)


def rope_tables(length, dim):
    inv_freq = ROPE_THETA ** (-jnp.arange(0, dim, 2, dtype=jnp.float32) / dim)
    ang = jnp.arange(length, dtype=jnp.float32)[:, None] * inv_freq[None, :]
    return jnp.cos(ang), jnp.sin(ang)


def apply_rope(x, cos, sin):
    half = x.shape[-1] // 2
    x1, x2 = x[..., :half], x[..., half:]
    out = jnp.concatenate([x1 * cos - x2 * sin, x2 * cos + x1 * sin], axis=-1)
    return out.astype(x.dtype)


def conformer_conv_branch(a, g, z, w_dw, b_dw, ln_g, ln_b):
    u = a * jax.nn.sigmoid(g)
    u = lax.conv_general_dilated(
        u, w_dw[:, None, :].astype(u.dtype), window_strides=(1,),
        padding=[(CONV_WIDTH - 1, 0)],
        dimension_numbers=('NWC', 'WIO', 'NWC'),
        feature_group_count=D_CONV) + b_dw
    u = jax.nn.silu(layer_norm(u, ln_g, ln_b))
    return u * jax.nn.silu(z)


def dsa_sparse_attention(q, k, v, qi, ki, wi, topk):
    B, L = q.shape[0], q.shape[1]
    nb = L // Q_BLOCK
    key_pos = jnp.arange(L)
    ki32 = ki.astype(jnp.float32)

    def to_blocks(t):
        return jnp.moveaxis(t.reshape((B, nb, Q_BLOCK) + t.shape[2:]), 1, 0)

    def one_block(args):
        qb, qib, wib, start = args
        q_pos = start + jnp.arange(Q_BLOCK)
        causal = key_pos[None, :] <= q_pos[:, None]
        logits = jnp.einsum('bqhd,bsd->bqhs', qib.astype(jnp.float32), ki32) * IDX_SCALE
        score = jnp.einsum('bqhs,bqh->bqs', jax.nn.relu(logits),
                           wib.astype(jnp.float32) * IDX_W_SCALE)
        score = jnp.where(causal[None], score, -jnp.inf)
        _, idx = lax.top_k(score, topk)
        valid = idx <= q_pos[None, :, None]
        kg = jax.vmap(lambda kk, ii: kk[ii])(k, idx)
        vg = jax.vmap(lambda vv, ii: vv[ii])(v, idx)
        s = jnp.einsum('bqhd,bqkhd->bqhk', qb, kg).astype(jnp.float32) * (HEAD_DIM ** -0.5)
        s = jnp.where(valid[:, :, None, :], s, -jnp.inf)
        p = jax.nn.softmax(s, axis=-1).astype(v.dtype)
        return jnp.einsum('bqhk,bqkhd->bqhd', p, vg)

    starts = jnp.arange(nb) * Q_BLOCK
    out = lax.map(one_block, (to_blocks(q), to_blocks(qi), to_blocks(wi), starts))
    return jnp.moveaxis(out, 0, 1).reshape(B, L, D_ATTN)


def setup_inputs(seed: int = 0) -> dict:
    key = jax.random.key(seed)
    ks = jax.random.split(key, 10)
    f32 = jnp.float32
    x = jax.random.normal(ks[0], (BATCH, SEQ, D_MODEL), f32)
    meta_tokens = jax.random.normal(ks[1], (N_META, D_MODEL), f32)
    w_in = jax.random.normal(ks[2], (DEPTH, D_MODEL, D_IN), f32) * D_MODEL ** -0.5
    conv_w = jax.random.normal(ks[3], (DEPTH, CONV_WIDTH, D_CONV), f32) * CONV_WIDTH ** -0.5
    conv_b = 0.01 * jax.random.normal(ks[4], (DEPTH, D_CONV), f32)
    conv_ln_g = 1.0 + 0.01 * jax.random.normal(ks[5], (DEPTH, D_CONV), f32)
    conv_ln_b = 0.01 * jax.random.normal(ks[6], (DEPTH, D_CONV), f32)
    w_out = jax.random.normal(ks[7], (DEPTH, D_MIX, D_MODEL), f32) * (D_MIX ** -0.5) * DEEPNORM_BETA
    post_ln_g = 1.0 + 0.01 * jax.random.normal(ks[8], (DEPTH, D_MODEL), f32)
    post_ln_b = 0.01 * jax.random.normal(ks[9], (DEPTH, D_MODEL), f32)
    return {"x": x, "meta_tokens": meta_tokens, "w_in": w_in, "conv_w": conv_w,
            "conv_b": conv_b, "conv_ln_g": conv_ln_g, "conv_ln_b": conv_ln_b,
            "w_out": w_out, "post_ln_g": post_ln_g, "post_ln_b": post_ln_b}


def reference(x, meta_tokens, w_in, conv_w, conv_b, conv_ln_g, conv_ln_b, w_out,
              post_ln_g, post_ln_b):
    B, S, D = x.shape
    L = S + N_META
    topk = min(TOPK_MAX, L // 4)
    Lp = -(-L // POS_BLOCK) * POS_BLOCK
    meta = jnp.broadcast_to(meta_tokens[None].astype(x.dtype), (B, N_META, D))
    h = jnp.concatenate([meta, x, jnp.zeros((B, Lp - L, D), x.dtype)], axis=1)
    cos, sin = rope_tables(Lp, HEAD_DIM)
    cos_h, sin_h = cos[:, None, :], sin[:, None, :]

    for l in range(DEPTH):
        proj = jnp.einsum('bld,de->ble', h, w_in[l])
        a, g, zc, q, k, v, za, qi, ki, wi = jnp.split(proj, IN_SPLITS, axis=-1)
        y_conv = conformer_conv_branch(a, g, zc, conv_w[l], conv_b[l], conv_ln_g[l], conv_ln_b[l])
        q = apply_rope(q.reshape(B, Lp, N_HEADS, HEAD_DIM), cos_h, sin_h)
        k = apply_rope(k.reshape(B, Lp, N_HEADS, HEAD_DIM), cos_h, sin_h)
        v = v.reshape(B, Lp, N_HEADS, HEAD_DIM)
        qi = apply_rope(qi.reshape(B, Lp, N_IDX_HEADS, IDX_DIM), cos_h, sin_h)
        ki = apply_rope(ki, cos, sin)
        y_attn = dsa_sparse_attention(q, k, v, qi, ki, wi, topk) * jax.nn.silu(za)
        y = jnp.einsum('ble,ed->bld', jnp.concatenate([y_conv, y_attn], axis=-1), w_out[l])
        h = layer_norm(DEEPNORM_ALPHA * h + y, post_ln_g[l], post_ln_b[l])

    return h[:, N_META:L]
```

```cpp
#include <hip/hip_runtime.h>
#include <hip/hip_cooperative_groups.h>
#include <cstdio>
#include <cstdint>
namespace cg = cooperative_groups;
namespace pg8 {
#define PG8_LAS __attribute__((address_space(3)))
typedef unsigned short bf16_t;
typedef short bf16x8 __attribute__((ext_vector_type(8)));
typedef float f32x4 __attribute__((ext_vector_type(4)));
typedef unsigned u32x4 __attribute__((ext_vector_type(4)));
constexpr int BM = 256, BK = 64, HALF = 128, HTB = HALF * BK * 2  , STAGE_BYTES = 8 * HTB, NXCD = 8, WGM = 8;

__host__ __device__ __forceinline__ int lds_byte(int r, int c) { const int st = (r >> 4) * 2 + (c >> 5), rr = r & 15, cc = c & 31, ob = rr * 64 + cc * 2; return st * 1024 + (ob ^ (((ob >> 9) & 1) << 5)); }
__host__ __device__ __forceinline__ void stage_rc(int b, int& R, int& C) { const int st = b / 1024, sb = b % 1024, swz = sb ^ (((sb >> 9) & 1) << 5); R = (st >> 1) * 16 + swz / 64; C = (st & 1) * 32 + (swz % 64) / 2; }
__host__ __device__ __forceinline__ int perm32(int rho) { const int n = rho >> 4, i = rho & 15; return 8 * (i >> 2) + 4 * n + (i & 3); }

struct Unit { int pm, pn; };
struct Gemm { const bf16_t* A; const bf16_t* Bt; int M, N, K; };

struct StaticOrder {
    int nM, nN, nwg, G, c;
    __host__ __device__ void init(int M, int N, int G_, int c_) { nM = M / BM; nN = N / BM; nwg = nM * nN; G = G_; c = c_; }
    __host__ __device__ bool next(int i, Unit& u) const {
        const long L = (long)i * G + c; if (L >= nwg) return false;
        int wgid = (int)L; { const int q = nwg / NXCD, r = nwg % NXCD, xcd = wgid % NXCD, off = wgid / NXCD; wgid = (xcd < r ? xcd * (q + 1) : r * (q + 1) + (xcd - r) * q) + off; }
        const int nig = WGM * nN, gid = wgid / nig, fm = gid * WGM, gsz = (nM - fm) < WGM ? (nM - fm) : WGM;
        u.pm = fm + ((wgid % nig) % gsz); u.pn = (wgid % nig) / gsz; return true;
    }
    __device__ __forceinline__ void a_ready(const Unit&) const {}
    __device__ __forceinline__ void done(const Unit&) const {}
};
template <class Epi, class Sched, bool ALIGN_EPI = false, bool SP2 = false>
__device__ __forceinline__ void gemm_phase(PG8_LAS unsigned char* lds, const Gemm g, const Sched& S, const Epi& E) {
    int tid = threadIdx.x; asm volatile("" : "+v"(tid)); const int wid = __builtin_amdgcn_readfirstlane(tid >> 6), lane = tid & 63, wr = wid >> 2, wc = wid & 3, fr = lane & 15, fq = lane >> 4;
    const int K = g.K, nt = K / BK;
    unsigned voffA[2], voffB[2];
#pragma unroll
    for (int i = 0; i < 2; ++i) { int R, C; stage_rc(tid * 16 + i * 8192, R, C); const int Rb = Epi::PERM ? ((R & ~31) + perm32(R & 31)) : R;
        voffA[i] = (unsigned)(R * K + C) * 2u; voffB[i] = (unsigned)(Rb * K + C) * 2u; }
    const size_t kstep = (size_t)(BK * 2);
    const size_t hstep = (size_t)HALF * K * 2;
    const size_t tstep = 2 * hstep;
    const unsigned ldsw = (unsigned)wid * 1024u;
    const int aoff = lds_byte(wr * 64 + fr, fq * 8), boff = lds_byte(wc * 32 + fr, fq * 8);
#define PG8_SA(b, h) (((b) * 2 + (h)) * HTB)
#define PG8_SB(b, h) ((4 + (b) * 2 + (h)) * HTB)
#define PG8_STAGE(bufoff, gbase, voff) do { _Pragma("unroll") for (int _i = 0; _i < 2; ++_i) \
        __builtin_amdgcn_global_load_lds((const unsigned*)((const char*)(gbase) + (voff)[_i]), (PG8_LAS unsigned*)(lds + (bufoff) + ldsw + _i * 8192), 16, 0, 0); } while (0)
#define PG8_LDA(dst, b, h) do { _Pragma("unroll") for (int m = 0; m < 4; ++m) _Pragma("unroll") for (int k = 0; k < 2; ++k) dst[m][k] = *(const PG8_LAS bf16x8*)(lds + PG8_SA(b, h) + aoff + m * 2048 + k * 1024); } while (0)
#define PG8_LDB(dst, b, h) do { _Pragma("unroll") for (int n = 0; n < 2; ++n) _Pragma("unroll") for (int k = 0; k < 2; ++k) dst[n][k] = *(const PG8_LAS bf16x8*)(lds + PG8_SB(b, h) + boff + n * 2048 + k * 1024); } while (0)
#define PG8_MMA(ai, bj, At, Bt) do { __builtin_amdgcn_s_setprio(1); _Pragma("unroll") for (int m = 0; m < 4; ++m) _Pragma("unroll") for (int n = 0; n < 2; ++n) _Pragma("unroll") for (int k = 0; k < 2; ++k) \
        acc[ai][bj][m][n] = __builtin_amdgcn_mfma_f32_16x16x32_bf16(Bt[n][k], At[m][k], acc[ai][bj][m][n], 0, 0, 0); __builtin_amdgcn_s_setprio(0); } while (0)
#define PG8_WAIT_V(n) asm volatile("s_waitcnt vmcnt(" #n ")" ::: "memory")
#define PG8_WAIT_L(n) asm volatile("s_waitcnt lgkmcnt(" #n ")" ::: "memory")
#define PG8_BAR __builtin_amdgcn_s_barrier()
#define PG8_SCHED __builtin_amdgcn_sched_barrier(0)
    Unit cur, nxt; int ui = 0;
    if (!S.next(0, cur)) return;
    f32x4 acc[2][2][4][2];
#pragma unroll
    for (int a = 0; a < 2; ++a)
#pragma unroll
        for (int b = 0; b < 2; ++b)
#pragma unroll
            for (int m = 0; m < 4; ++m)
#pragma unroll
                for (int n = 0; n < 2; ++n) acc[a][b][m][n] = (f32x4){0.f, 0.f, 0.f, 0.f};
    bf16x8 At[4][2], B0[2][2], B1[2][2];
    const char* cA = (const char*)g.A + (size_t)cur.pm * tstep; const char* cB = (const char*)g.Bt + (size_t)cur.pn * tstep;
    S.a_ready(cur);
    if constexpr (SP2) {
        PG8_STAGE(PG8_SB(0, 0), cB, voffB); PG8_STAGE(PG8_SB(0, 1), cB + hstep, voffB); PG8_STAGE(PG8_SA(0, 0), cA, voffA); PG8_STAGE(PG8_SA(0, 1), cA + hstep, voffA);
        if (wr == 1) PG8_BAR;
        PG8_WAIT_V(2); PG8_BAR;
        PG8_STAGE(PG8_SB(1, 0), cB + kstep, voffB); PG8_STAGE(PG8_SA(1, 0), cA + kstep, voffA); PG8_STAGE(PG8_SB(1, 1), cB + hstep + kstep, voffB);
        PG8_WAIT_V(6); PG8_BAR;
    } else {
        PG8_STAGE(PG8_SB(0, 0), cB, voffB); PG8_STAGE(PG8_SA(0, 0), cA, voffA); PG8_STAGE(PG8_SB(0, 1), cB + hstep, voffB); PG8_STAGE(PG8_SA(0, 1), cA + hstep, voffA);
        if (wr == 1) PG8_BAR;
        PG8_WAIT_V(4); PG8_BAR;
        PG8_STAGE(PG8_SB(1, 0), cB + kstep, voffB); PG8_STAGE(PG8_SA(1, 0), cA + kstep, voffA); PG8_STAGE(PG8_SB(1, 1), cB + hstep + kstep, voffB);
        PG8_WAIT_V(6); PG8_BAR;
    }
    for (;;) {
        const bool has_next = S.next(ui + 1, nxt);
        const char* nA = has_next ? (const char*)g.A + (size_t)nxt.pm * tstep : cA; const char* nB = has_next ? (const char*)g.Bt + (size_t)nxt.pn * tstep : cB;
        for (int t = 0; t < nt; t += 2) {
            const bool last = (t == nt - 2);
            const char* a1 = cA + (size_t)(t + 1) * kstep;
            const char* a2 = last ? nA : cA + (size_t)(t + 2) * kstep; const char* b2 = last ? nB : cB + (size_t)(t + 2) * kstep;
            const char* a3 = a2 + kstep; const char* b3 = b2 + kstep;
            if (last && has_next) S.a_ready(nxt);
            if constexpr (SP2) {
            PG8_LDB(B0, 0, 0); PG8_LDB(B1, 0, 1); PG8_SCHED; PG8_LDA(At, 0, 0); PG8_STAGE(PG8_SA(1, 1), a1 + hstep, voffA);
            PG8_WAIT_V(8); PG8_WAIT_L(0); PG8_BAR; PG8_MMA(0, 0, At, B0); PG8_MMA(0, 1, At, B1); PG8_BAR; PG8_SCHED;
            PG8_LDA(At, 0, 1); PG8_STAGE(PG8_SB(0, 0), b2, voffB); PG8_STAGE(PG8_SB(0, 1), b2 + hstep, voffB); PG8_STAGE(PG8_SA(0, 0), a2, voffA);
            PG8_WAIT_V(8); PG8_WAIT_L(0); PG8_BAR; PG8_MMA(1, 0, At, B0); PG8_MMA(1, 1, At, B1); PG8_BAR; PG8_SCHED;
            PG8_LDB(B0, 1, 0); PG8_LDB(B1, 1, 1); PG8_SCHED; PG8_LDA(At, 1, 0); PG8_STAGE(PG8_SA(0, 1), a2 + hstep, voffA);
            PG8_WAIT_V(8); PG8_WAIT_L(0); PG8_BAR; PG8_MMA(0, 0, At, B0); PG8_MMA(0, 1, At, B1); PG8_BAR; PG8_SCHED;
            PG8_LDA(At, 1, 1); PG8_STAGE(PG8_SB(1, 0), b3, voffB); PG8_STAGE(PG8_SB(1, 1), b3 + hstep, voffB); PG8_STAGE(PG8_SA(1, 0), a3, voffA);
            PG8_WAIT_V(8); PG8_WAIT_L(0); PG8_BAR; PG8_MMA(1, 0, At, B0); PG8_MMA(1, 1, At, B1); PG8_BAR; PG8_SCHED;
            } else {
            PG8_LDB(B0, 0, 0); PG8_SCHED; PG8_LDA(At, 0, 0); PG8_STAGE(PG8_SA(1, 1), a1 + hstep, voffA);
            PG8_WAIT_L(8); PG8_BAR; PG8_WAIT_L(0); PG8_MMA(0, 0, At, B0); PG8_BAR; PG8_SCHED;
            PG8_LDB(B1, 0, 1); PG8_STAGE(PG8_SB(0, 0), b2, voffB);
            PG8_BAR; PG8_WAIT_L(0); PG8_MMA(0, 1, At, B1); PG8_BAR;
            PG8_LDA(At, 0, 1); PG8_STAGE(PG8_SA(0, 0), a2, voffA);
            PG8_BAR; PG8_WAIT_L(0); PG8_MMA(1, 0, At, B0); PG8_BAR; PG8_SCHED;
            PG8_STAGE(PG8_SB(0, 1), b2 + hstep, voffB);
            PG8_WAIT_V(6); PG8_BAR; PG8_MMA(1, 1, At, B1); PG8_BAR;
            PG8_LDB(B0, 1, 0); PG8_SCHED; PG8_LDA(At, 1, 0); PG8_STAGE(PG8_SA(0, 1), a2 + hstep, voffA);
            PG8_WAIT_L(8); PG8_BAR; PG8_WAIT_L(0); PG8_MMA(0, 0, At, B0); PG8_BAR; PG8_SCHED;
            PG8_LDB(B1, 1, 1); PG8_STAGE(PG8_SB(1, 0), b3, voffB);
            PG8_BAR; PG8_WAIT_L(0); PG8_MMA(0, 1, At, B1); PG8_BAR;
            PG8_LDA(At, 1, 1); PG8_STAGE(PG8_SA(1, 0), a3, voffA);
            PG8_BAR; PG8_WAIT_L(0); PG8_MMA(1, 0, At, B0); PG8_BAR; PG8_SCHED;
            PG8_STAGE(PG8_SB(1, 1), b3 + hstep, voffB);
            PG8_WAIT_V(6); PG8_BAR; PG8_MMA(1, 1, At, B1); PG8_BAR;
            }
        }
        if constexpr (ALIGN_EPI) { if (wr == 0) PG8_BAR; }
        if constexpr (!Epi::AFTER_DRAIN) { E(acc, cur, wr, wc, fr, fq); S.done(cur); }
        if (!has_next) break;
#pragma unroll
        for (int a = 0; a < 2; ++a)
#pragma unroll
            for (int b = 0; b < 2; ++b)
#pragma unroll
                for (int m = 0; m < 4; ++m)
#pragma unroll
                    for (int n = 0; n < 2; ++n) acc[a][b][m][n] = (f32x4){0.f, 0.f, 0.f, 0.f};
        cur = nxt; cA = nA; cB = nB; ++ui;
        if constexpr (ALIGN_EPI) { if (wr == 1) PG8_BAR; }
    }
    PG8_WAIT_V(0);
    if constexpr (!ALIGN_EPI) { if (wr == 0) PG8_BAR; }
    PG8_BAR;
    if constexpr (Epi::AFTER_DRAIN) { E.fused(acc, cur, wr, wc, fr, fq, lds, wid, lane); S.done(cur); }
#undef PG8_SA
#undef PG8_SB
#undef PG8_STAGE
#undef PG8_LDA
#undef PG8_LDB
#undef PG8_MMA
#undef PG8_WAIT_V
#undef PG8_WAIT_L
#undef PG8_BAR
#undef PG8_SCHED
}
}

#define LAS __attribute__((address_space(3)))
typedef unsigned short bf16_t;
typedef short bf16x8 __attribute__((ext_vector_type(8)));
typedef short s16x4 __attribute__((ext_vector_type(4)));
typedef float f32x4 __attribute__((ext_vector_type(4)));
typedef float f32x2 __attribute__((ext_vector_type(2)));
typedef float f32x16 __attribute__((ext_vector_type(16)));
typedef unsigned u32x4 __attribute__((ext_vector_type(4)));
typedef unsigned u32x2 __attribute__((ext_vector_type(2)));
typedef __bf16 bf16x2_t __attribute__((ext_vector_type(2)));

constexpr int NB = 8, SEQ = 4096, DM = 1024, DEPTH = 4, NMETA = 16;
constexpr int LV = SEQ + NMETA;
constexpr int LP = 4224;
constexpr int NR = NB * LP;
constexpr int DIN = 4168, NPAD = 4352;
constexpr int BW = 132;
constexpr float LN_EPS = 1e-5f;
constexpr float DN_ALPHA = 1.681792830507429f;
constexpr float QSCALE = 0.125f * 1.4426950408889634f;
constexpr float IDX_W_SCALE = 0.35355339059327373f;
constexpr int SSTR = 4232;
constexpr int LDS_BYTES = 157696;

constexpr size_t al256(size_t x) { return (x + 255) & ~(size_t)255; }
constexpr size_t WS_BAR = 0;
constexpr size_t WS_COS = 16384;
constexpr size_t WS_SIN = WS_COS + al256((size_t)LP * 32 * 4);
constexpr size_t WS_WIN = WS_SIN + al256((size_t)LP * 32 * 4);
constexpr size_t WS_WOUT = WS_WIN + (size_t)DEPTH * NPAD * 1024 * 2;
constexpr size_t WS_HB = WS_WOUT + (size_t)DEPTH * 1024 * 1024 * 2;
constexpr size_t SZ512 = (size_t)NR * 512 * 2;
constexpr size_t WS_U = WS_HB + (size_t)NR * 1024 * 2;
constexpr size_t WS_ZC = WS_U + SZ512;
constexpr size_t WS_Q = WS_ZC + SZ512;
constexpr size_t WS_K = WS_Q + SZ512;
constexpr size_t WS_V = WS_K + SZ512;
constexpr size_t WS_ZA = WS_V + SZ512;
constexpr size_t WS_QI = WS_ZA + SZ512;
constexpr size_t WS_KI = WS_QI + SZ512;
constexpr size_t WS_WI = WS_KI + (size_t)NR * 64 * 2;
constexpr size_t WS_YMIX = WS_WI + (size_t)NR * 8 * 4;
constexpr size_t WS_BITS = WS_YMIX + (size_t)NR * 1024 * 2;
constexpr size_t WS_METAH = WS_BITS + (size_t)NR * BW * 4;
constexpr size_t WS_STAT = WS_METAH + (size_t)NB * NMETA * 1024 * 4;
constexpr size_t WS_DUMP = WS_STAT + (size_t)NR * 2 * 4;
constexpr size_t WS_END = WS_DUMP + 4096;

struct Params {
    const float* x; const float* meta; const float* w_in; const float* conv_w; const float* conv_b;
    const float* conv_ln_g; const float* conv_ln_b; const float* w_out; const float* post_g; const float* post_b;
    float* out; unsigned char* ws;
};

__device__ __forceinline__ unsigned pk2(float lo, float hi) { f32x2 v = {lo, hi}; bf16x2_t b = __builtin_convertvector(v, bf16x2_t); return __builtin_bit_cast(unsigned, b); }
__device__ __forceinline__ float bflo(unsigned w) { return __uint_as_float(w << 16); }
__device__ __forceinline__ float bfhi(unsigned w) { return __uint_as_float(w & 0xffff0000u); }
__device__ __forceinline__ float sigmoidf_(float x) { return __builtin_amdgcn_rcpf(1.0f + __expf(-x)); }
__device__ __forceinline__ float wave_sum(float v) {
#pragma unroll
    for (int o = 1; o < 64; o <<= 1) v += __shfl_xor(v, o);
    return v;
}

__device__ __forceinline__ int in_colmap(int c) {
    const int pn = c >> 8, w = c & 255;
    if (pn < 4) return (w < 128) ? (128 * pn + w) : (512 + 128 * pn + (w - 128));
    if (pn == 16) { if (w < 64) return 4096 + (w >> 1) + 32 * (w & 1); if (w < 72) return 4160 + (w - 64); return -1; }
    const int kind = (pn - 4) >> 1;
    const int base = 1024 + 512 * kind + 256 * (pn & 1);
    if (kind == 1 || kind == 2 || kind == 5) return base + 64 * (w >> 6) + ((w & 63) >> 1) + 32 * (w & 1);
    return base + w;
}

struct EpiIn {
    static constexpr bool PERM = true, AFTER_DRAIN = false;
    bf16_t *U, *ZC, *Q, *K, *V, *ZA, *QI, *KI; float* WI; const float* cosT; const float* sinT;
    __device__ __forceinline__ void operator()(const pg8::f32x4 (&acc)[2][2][4][2], const pg8::Unit& u, int wr, int wc, int fr, int fq) const {
        const int pn = u.pn;
        const int row0 = u.pm * 256 + wr * 64 + fr;
        const int w0 = wc * 32 + 8 * fq;
        if (pn < 4) {
#pragma unroll
            for (int ai = 0; ai < 2; ++ai)
#pragma unroll
                for (int m = 0; m < 4; ++m) {
                    const int r = row0 + ai * 128 + m * 16;
                    const pg8::f32x4 a0 = acc[ai][0][m][0], a1 = acc[ai][0][m][1], g0 = acc[ai][1][m][0], g1 = acc[ai][1][m][1];
                    u32x4 w;
                    w.x = pk2(a0[0] * sigmoidf_(g0[0]), a0[1] * sigmoidf_(g0[1])); w.y = pk2(a0[2] * sigmoidf_(g0[2]), a0[3] * sigmoidf_(g0[3]));
                    w.z = pk2(a1[0] * sigmoidf_(g1[0]), a1[1] * sigmoidf_(g1[1])); w.w = pk2(a1[2] * sigmoidf_(g1[2]), a1[3] * sigmoidf_(g1[3]));
                    *(u32x4*)(U + (size_t)r * 512 + pn * 128 + w0) = w;
                }
        } else if (pn == 16) {
            if (w0 < 64) {
                const int i0 = w0 >> 1;
#pragma unroll
                for (int ai = 0; ai < 2; ++ai)
#pragma unroll
                    for (int m = 0; m < 4; ++m) {
                        const int r = row0 + ai * 128 + m * 16; const int t = r % LP;
                        const f32x4 c4 = *(const f32x4*)(cosT + t * 32 + i0), s4 = *(const f32x4*)(sinT + t * 32 + i0);
                        const pg8::f32x4 v0 = acc[ai][0][m][0], v1 = acc[ai][0][m][1];
                        u32x4 w;
                        w.x = pk2(v0[0] * c4[0] - v0[1] * s4[0], v0[1] * c4[0] + v0[0] * s4[0]);
                        w.y = pk2(v0[2] * c4[1] - v0[3] * s4[1], v0[3] * c4[1] + v0[2] * s4[1]);
                        w.z = pk2(v1[0] * c4[2] - v1[1] * s4[2], v1[1] * c4[2] + v1[0] * s4[2]);
                        w.w = pk2(v1[2] * c4[3] - v1[3] * s4[3], v1[3] * c4[3] + v1[2] * s4[3]);
                        *(u32x4*)(KI + (size_t)r * 64 + w0) = w;
                    }
            } else if (w0 == 64) {
#pragma unroll
                for (int ai = 0; ai < 2; ++ai)
#pragma unroll
                    for (int m = 0; m < 4; ++m) {
                        const int r = row0 + ai * 128 + m * 16;
                        *(f32x4*)(WI + (size_t)r * 8) = acc[ai][0][m][0] * IDX_W_SCALE;
                        *(f32x4*)(WI + (size_t)r * 8 + 4) = acc[ai][0][m][1] * IDX_W_SCALE;
                    }
            }
        } else {
            const int kind = (pn - 4) >> 1;
            bf16_t* base = kind == 0 ? ZC : kind == 1 ? Q : kind == 2 ? K : kind == 3 ? V : kind == 4 ? ZA : QI;
            const int cb = (pn & 1) * 256 + w0;
            if (kind == 0 || kind == 4) {
#pragma unroll
                for (int ai = 0; ai < 2; ++ai)
#pragma unroll
                    for (int m = 0; m < 4; ++m) {
                        const int r = row0 + ai * 128 + m * 16;
#pragma unroll
                        for (int bj = 0; bj < 2; ++bj) {
                            const pg8::f32x4 v0 = acc[ai][bj][m][0], v1 = acc[ai][bj][m][1];
                            u32x4 w;
                            w.x = pk2(v0[0] * sigmoidf_(v0[0]), v0[1] * sigmoidf_(v0[1])); w.y = pk2(v0[2] * sigmoidf_(v0[2]), v0[3] * sigmoidf_(v0[3]));
                            w.z = pk2(v1[0] * sigmoidf_(v1[0]), v1[1] * sigmoidf_(v1[1])); w.w = pk2(v1[2] * sigmoidf_(v1[2]), v1[3] * sigmoidf_(v1[3]));
                            *(u32x4*)(base + (size_t)r * 512 + cb + bj * 128) = w;
                        }
                    }
            } else if (kind == 3) {
#pragma unroll
                for (int ai = 0; ai < 2; ++ai)
#pragma unroll
                    for (int m = 0; m < 4; ++m) {
                        const int r = row0 + ai * 128 + m * 16;
#pragma unroll
                        for (int bj = 0; bj < 2; ++bj) {
                            const pg8::f32x4 v0 = acc[ai][bj][m][0], v1 = acc[ai][bj][m][1];
                            u32x4 w; w.x = pk2(v0[0], v0[1]); w.y = pk2(v0[2], v0[3]); w.z = pk2(v1[0], v1[1]); w.w = pk2(v1[2], v1[3]);
                            *(u32x4*)(base + (size_t)r * 512 + cb + bj * 128) = w;
                        }
                    }
            } else {
                const float sc = kind == 1 ? QSCALE : kind == 5 ? 0.125f : 1.0f;
                const int i0 = (w0 & 63) >> 1;
                f32x4 cN = *(const f32x4*)(cosT + (row0 % LP) * 32 + i0), sN = *(const f32x4*)(sinT + (row0 % LP) * 32 + i0);
#pragma unroll
                for (int g8 = 0; g8 < 8; ++g8) {
                    const int ai = g8 >> 2, m = g8 & 3;
                    const int r = row0 + ai * 128 + m * 16;
                    const f32x4 c4 = cN * sc, s4 = sN * sc;
                    if (g8 < 7) { const int rn = row0 + ((g8 + 1) >> 2) * 128 + ((g8 + 1) & 3) * 16; const int tn = rn % LP; cN = *(const f32x4*)(cosT + tn * 32 + i0); sN = *(const f32x4*)(sinT + tn * 32 + i0); }
#pragma unroll
                    for (int bj = 0; bj < 2; ++bj) {
                        const pg8::f32x4 v0 = acc[ai][bj][m][0], v1 = acc[ai][bj][m][1];
                        u32x4 w;
                        w.x = pk2(v0[0] * c4[0] - v0[1] * s4[0], v0[1] * c4[0] + v0[0] * s4[0]);
                        w.y = pk2(v0[2] * c4[1] - v0[3] * s4[1], v0[3] * c4[1] + v0[2] * s4[1]);
                        w.z = pk2(v1[0] * c4[2] - v1[1] * s4[2], v1[1] * c4[2] + v1[0] * s4[2]);
                        w.w = pk2(v1[2] * c4[3] - v1[3] * s4[3], v1[3] * c4[3] + v1[2] * s4[3]);
                        *(u32x4*)(base + (size_t)r * 512 + cb + bj * 128) = w;
                    }
                }
            }
        }
    }
};

struct EpiOut {
    static constexpr bool PERM = false, AFTER_DRAIN = false;
    const float* src_main; const float* src_meta; int src_meta_bstride; float* dst_main; float* dst_meta;
    const float* stat; const float* pg; const float* pb;
    float* dump;
    __device__ __forceinline__ void rowp(int r, const float*& sp, float*& dp) const {
        const int b = r / LP, t = r - b * LP;
        if (t < NMETA) { sp = src_meta + (size_t)b * src_meta_bstride + t * 1024; dp = dst_meta + (size_t)(b * NMETA + t) * 1024; }
        else { const int tt = t < LV ? t : NMETA; const size_t o = ((size_t)b * SEQ + (tt - NMETA)) * 1024; sp = src_main + o; dp = (t < LV) ? (dst_main + o) : dump; }
    }
    __device__ __forceinline__ void operator()(const pg8::f32x4 (&acc)[2][2][4][2], const pg8::Unit& u, int wr, int wc, int fr, int fq) const {
        const int col0 = u.pn * 256 + wc * 32 + 4 * fq;
        const int row0 = u.pm * 256 + wr * 64 + fr;
        const bool rebuild = stat != nullptr;
        f32x4 g4[2][2], b4[2][2];
#pragma unroll
        for (int bj = 0; bj < 2; ++bj)
#pragma unroll
            for (int n = 0; n < 2; ++n) { g4[bj][n] = (f32x4){1.f, 1.f, 1.f, 1.f}; b4[bj][n] = (f32x4){0.f, 0.f, 0.f, 0.f};
                if (rebuild) { g4[bj][n] = *(const f32x4*)(pg + col0 + bj * 128 + n * 16); b4[bj][n] = *(const f32x4*)(pb + col0 + bj * 128 + n * 16); } }
        const float* spn; float* dpn; rowp(row0, spn, dpn);
        f32x4 hvn[2][2]; f32x2 stn = {0.f, 1.f};
#pragma unroll
        for (int bj = 0; bj < 2; ++bj)
#pragma unroll
            for (int n = 0; n < 2; ++n) hvn[bj][n] = *(const f32x4*)(spn + col0 + bj * 128 + n * 16);
        if (rebuild) stn = *(const f32x2*)(stat + (size_t)row0 * 2);
#pragma unroll
        for (int g8 = 0; g8 < 8; ++g8) {
            const int ai = g8 >> 2, m = g8 & 3;
            f32x4 hv[2][2]; const f32x2 st = stn; float* dp = dpn;
#pragma unroll
            for (int bj = 0; bj < 2; ++bj)
#pragma unroll
                for (int n = 0; n < 2; ++n) hv[bj][n] = hvn[bj][n];
            if (g8 < 7) {
                const int rn = row0 + ((g8 + 1) >> 2) * 128 + ((g8 + 1) & 3) * 16; rowp(rn, spn, dpn);
#pragma unroll
                for (int bj = 0; bj < 2; ++bj)
#pragma unroll
                    for (int n = 0; n < 2; ++n) hvn[bj][n] = *(const f32x4*)(spn + col0 + bj * 128 + n * 16);
                if (rebuild) stn = *(const f32x2*)(stat + (size_t)rn * 2);
            }
#pragma unroll
            for (int bj = 0; bj < 2; ++bj)
#pragma unroll
                for (int n = 0; n < 2; ++n) {
                    f32x4 h = hv[bj][n];
                    if (rebuild) h = (h - st[0]) * st[1] * g4[bj][n] + b4[bj][n];
                    *(f32x4*)(dp + col0 + bj * 128 + n * 16) = h * DN_ALPHA + acc[ai][bj][m][n];
                }
        }
    }
};

template <bool MAPPED>
__device__ __forceinline__ void p0_transpose_item(const float* W, int N, bf16_t* WT, LAS float* scr, int kb, int nb, int lane) {
    const int k0 = 64 * kb, n0 = 32 * nb;
    const int col = MAPPED ? in_colmap(n0 + (lane & 31)) : (n0 + (lane & 31));
    float wreg[32];
#pragma unroll
    for (int i = 0; i < 32; ++i) { const int kk = 2 * i + (lane >> 5); wreg[i] = (col >= 0) ? W[(size_t)(k0 + kk) * N + col] : 0.f; }
#pragma unroll
    for (int i = 0; i < 32; ++i) { const int kk = 2 * i + (lane >> 5); scr[kk * 33 + (lane & 31)] = wreg[i]; }
    asm volatile("s_waitcnt lgkmcnt(0)" ::: "memory");
    const int c = lane & 7;
#pragma unroll
    for (int j = 0; j < 4; ++j) { const int n = (lane >> 3) + 8 * j; const LAS float* s = scr + (8 * c) * 33 + n;
        u32x4 o; o.x = pk2(s[0 * 33], s[1 * 33]); o.y = pk2(s[2 * 33], s[3 * 33]); o.z = pk2(s[4 * 33], s[5 * 33]); o.w = pk2(s[6 * 33], s[7 * 33]);
        *(u32x4*)(WT + (size_t)(n0 + n) * 1024 + k0 + 8 * c) = o; }
    asm volatile("s_waitcnt lgkmcnt(0)" ::: "memory");
}

__device__ __forceinline__ void p0_prologue(const Params& p, LAS unsigned char* lds, int wave, int lane) {
    unsigned char* ws = p.ws;
    LAS float* scr = (LAS float*)(lds + wave * 8704);
    const int gw = blockIdx.x * 8 + wave, NGW = gridDim.x * 8;
    constexpr int IT_IN = 16 * (NPAD / 32), IT_OUT = 16 * 32, IT_L = IT_IN + IT_OUT;
    for (int it = gw; it < DEPTH * IT_L; it += NGW) {
        const int l = it / IT_L; int r = it - l * IT_L;
        if (r < IT_IN) { const int kb = r / (NPAD / 32), nb = r - kb * (NPAD / 32);
            p0_transpose_item<true>(p.w_in + (size_t)l * 1024 * DIN, DIN, (bf16_t*)(ws + WS_WIN) + (size_t)l * NPAD * 1024, scr, kb, nb, lane); }
        else { r -= IT_IN; const int kb = r / 32, nb = r - kb * 32;
            p0_transpose_item<false>(p.w_out + (size_t)l * 1024 * 1024, 1024, (bf16_t*)(ws + WS_WOUT) + (size_t)l * 1024 * 1024, scr, kb, nb, lane); }
    }
    bf16_t* HB = (bf16_t*)(ws + WS_HB);
    for (int r0 = gw; r0 < NR; r0 += 4 * NGW) {
        f32x4 va[4][4]; bool live[4]; int rr[4];
#pragma unroll
        for (int k = 0; k < 4; ++k) {
            const int r = r0 + k * NGW; rr[k] = r; live[k] = false;
            const int rc = r < NR ? r : r0; const int b = rc / LP, t = rc - b * LP;
            const float* src = (t < NMETA) ? (p.meta + (size_t)t * 1024) : (p.x + ((size_t)b * SEQ + ((t < LV ? t : NMETA) - NMETA)) * 1024);
            live[k] = (r < NR) && (t < LV);
#pragma unroll
            for (int j = 0; j < 4; ++j) va[k][j] = *((const f32x4*)src + lane + 64 * j);
        }
#pragma unroll
        for (int k = 0; k < 4; ++k) {
            if (rr[k] < NR) {
                u32x2* o = (u32x2*)(HB + (size_t)rr[k] * 1024) + lane;
#pragma unroll
                for (int j = 0; j < 4; ++j) { u32x2 w; w.x = live[k] ? pk2(va[k][j][0], va[k][j][1]) : 0u; w.y = live[k] ? pk2(va[k][j][2], va[k][j][3]) : 0u; o[64 * j] = w; }
            }
        }
    }
    float* cosT = (float*)(ws + WS_COS); float* sinT = (float*)(ws + WS_SIN);
    for (int i = blockIdx.x * 512 + threadIdx.x; i < LP * 32; i += gridDim.x * 512) {
        const int t = i >> 5, f = i & 31;
        const float inv_freq = powf(10000.0f, -(float)(2 * f) / 64.0f);
        const float ang = (float)t * inv_freq;
        const double rev = (double)ang * 0.15915494309189535;
        const float fr = (float)(rev - floor(rev));
        cosT[i] = __builtin_amdgcn_cosf(fr); sinT[i] = __builtin_amdgcn_sinf(fr);
    }
}

#ifndef REP_SCORE
#define REP_SCORE 1
#endif
#ifndef REP_SEL
#define REP_SEL 1
#endif
constexpr int P2_HIST = 8 * SSTR * 4, P2_RS = P2_HIST + 8 * 512 * 4, P2_CAND = P2_RS + 64, P2_CIDX = P2_CAND + 8 * 64 * 4, P2_END = P2_CIDX + 8 * 64 * 4;
static_assert(P2_END <= LDS_BYTES, "P2 LDS map");
__device__ __forceinline__ int score_bin(float sc, float rs) { const float f = __builtin_amdgcn_fmed3f(__builtin_fmaf(sc, rs, 256.0f), 0.f, 511.f); return (int)f; }
__device__ __forceinline__ unsigned ord_key(float f) { const unsigned u = __float_as_uint(f); return (u & 0x80000000u) ? ~u : (u | 0x80000000u); }

__device__ __forceinline__ void select_bisect(const LAS float* Sr, unsigned long long* brow, int nj, int lane) {
    unsigned key[66];
#pragma unroll
    for (int j = 0; j < 66; ++j) { key[j] = 0u; if (j < nj) key[j] = ord_key(Sr[64 * j + lane]); }
    unsigned prefix = 0u; bool exact = false;
    for (int bit = 31; bit >= 0; --bit) {
        const unsigned cand = prefix | (1u << bit);
        int cnt = 0;
#pragma unroll
        for (int gq = 0; gq < 5; ++gq) if (gq * 16 < nj) {
#pragma unroll
            for (int jj = 0; jj < 16; ++jj) { const int j = gq * 16 + jj; if (j < 66) cnt += __popcll(__ballot(key[j] >= cand)); }
        }
        if (cnt >= 256) { prefix = cand; if (cnt == 256) { exact = true; break; } }
    }
    const unsigned thr = prefix;
    int need = 1 << 30;
    if (!exact) { int cgt = 0;
#pragma unroll
        for (int j = 0; j < 66; ++j) if (j < nj) cgt += __popcll(__ballot(key[j] > thr));
        need = 256 - cgt; }
    int eqb = 0;
#pragma unroll
    for (int j = 0; j < 66; ++j) if (j < nj) {
        const bool gt = key[j] > thr, eq = key[j] == thr;
        const unsigned long long em = __ballot(eq);
        const int rank = eqb + (int)__builtin_amdgcn_mbcnt_hi((unsigned)(em >> 32), __builtin_amdgcn_mbcnt_lo((unsigned)em, 0u));
        const bool sel = gt || (eq && rank < need);
        const unsigned long long sm = __ballot(sel);
        if (lane == 0) brow[j] = sm;
        eqb += __popcll(em);
    }
}

__device__ __forceinline__ void idx_item(int b, int g, const bf16_t* QI, const bf16_t* KI, const float* WI, unsigned* BITS, LAS unsigned char* lds, int tid, int wave, int lane) {
    LAS float* S = (LAS float*)lds; LAS unsigned* HIST = (LAS unsigned*)(lds + P2_HIST); LAS float* RS = (LAS float*)(lds + P2_RS);
    LAS unsigned* CAND = (LAS unsigned*)(lds + P2_CAND); LAS unsigned* CIDX = (LAS unsigned*)(lds + P2_CIDX);
    const int t0 = 8 * g; const int nj = t0 / 64 + 1; const int NT32 = 2 * nj;
    const int m = lane & 31, hh = lane >> 5;
#pragma unroll
    for (int i = 0; i < 8; ++i) HIST[tid + 512 * i] = 0u;
    if (tid < 8) { const float* wp = WI + (size_t)(b * LP + t0 + tid) * 8; const f32x4 lo = *(const f32x4*)wp, hi = *(const f32x4*)(wp + 4);
        const float ss = (lo[0] * lo[0] + lo[1] * lo[1]) + (lo[2] * lo[2] + lo[3] * lo[3]) + (hi[0] * hi[0] + hi[1] * hi[1]) + (hi[2] * hi[2] + hi[3] * hi[3]);
        RS[tid] = 32.0f / sqrtf(0.5f * ss + 1e-20f); }
    {
        const int aq = 2 * ((m >> 2) & 1) + (m >> 4), ah = 4 * ((m >> 3) & 1) + (m & 3);
        bf16x8 af[2][4];
#pragma unroll
        for (int mb = 0; mb < 2; ++mb)
#pragma unroll
            for (int ks = 0; ks < 4; ++ks) af[mb][ks] = *(const bf16x8*)(QI + (size_t)(b * LP + t0 + 4 * mb + aq) * 512 + ah * 64 + ks * 16 + hh * 8);
        float wv[2][2][8];
#pragma unroll
        for (int mb = 0; mb < 2; ++mb)
#pragma unroll
            for (int qq = 0; qq < 2; ++qq) { const size_t row = (size_t)(b * LP + t0 + 4 * mb + 2 * hh + qq);
                const f32x4 lo = *(const f32x4*)(WI + row * 8), hi = *(const f32x4*)(WI + row * 8 + 4);
                wv[mb][qq][0] = lo[0]; wv[mb][qq][1] = lo[1]; wv[mb][qq][2] = lo[2]; wv[mb][qq][3] = lo[3];
                wv[mb][qq][4] = hi[0]; wv[mb][qq][5] = hi[1]; wv[mb][qq][6] = hi[2]; wv[mb][qq][7] = hi[3]; }
        const bf16_t* kbase = KI + (size_t)(b * LP + m) * 64 + hh * 8;
#define IDX_LOADB(dst, tile) do { _Pragma("unroll") for (int ks = 0; ks < 4; ++ks) dst[ks] = *(const bf16x8*)(kbase + (size_t)(32 * (tile)) * 64 + ks * 16); } while (0)
        bf16x8 kb0[4], kb1[4], kb2[4];
        for (int rsc_ = 0; rsc_ < REP_SCORE; ++rsc_) {
        const bool dh = (rsc_ == REP_SCORE - 1);
        int tl = wave;
        if (tl < NT32) IDX_LOADB(kb0, tl);
        if (tl + 8 < NT32) IDX_LOADB(kb1, tl + 8);
        if (tl + 16 < NT32) IDX_LOADB(kb2, tl + 16);
        __syncthreads();
        float rsv[2][2];
#pragma unroll
        for (int mb = 0; mb < 2; ++mb)
#pragma unroll
            for (int qq = 0; qq < 2; ++qq) rsv[mb][qq] = RS[4 * mb + 2 * hh + qq];
#define IDX_TILE(kb, tile) do { \
            const int s = 32 * (tile) + m; \
            f32x16 c0 = {}, c1 = {}; \
            _Pragma("unroll") for (int ks = 0; ks < 4; ++ks) { c0 = __builtin_amdgcn_mfma_f32_32x32x16_bf16(af[0][ks], kb[ks], c0, 0, 0, 0); c1 = __builtin_amdgcn_mfma_f32_32x32x16_bf16(af[1][ks], kb[ks], c1, 0, 0, 0); } \
            if ((tile) + 24 < NT32) IDX_LOADB(kb, (tile) + 24); \
            _Pragma("unroll") for (int qq = 0; qq < 2; ++qq) { \
                float s0 = 0.f, s1 = 0.f;     \
                _Pragma("unroll") for (int h = 0; h < 8; ++h) { s0 = fmaf(wv[0][qq][h], __builtin_amdgcn_fmed3f(c0[8 * qq + h], 0.f, 3.0e38f), s0); s1 = fmaf(wv[1][qq][h], __builtin_amdgcn_fmed3f(c1[8 * qq + h], 0.f, 3.0e38f), s1); } \
                const int q0 = 2 * hh + qq, q1 = 4 + 2 * hh + qq; \
                if (s <= t0 + q0) { if (dh) __hip_atomic_fetch_add(HIST + q0 * 512 + score_bin(s0, rsv[0][qq]), 1u, __ATOMIC_RELAXED, __HIP_MEMORY_SCOPE_WORKGROUP); } else s0 = -INFINITY; \
                if (s <= t0 + q1) { if (dh) __hip_atomic_fetch_add(HIST + q1 * 512 + score_bin(s1, rsv[1][qq]), 1u, __ATOMIC_RELAXED, __HIP_MEMORY_SCOPE_WORKGROUP); } else s1 = -INFINITY; \
                S[q0 * SSTR + s] = s0; S[q1 * SSTR + s] = s1; \
            } } while (0)
        for (; tl < NT32; tl += 24) {
            IDX_TILE(kb0, tl);
            if (tl + 8 < NT32) IDX_TILE(kb1, tl + 8);
            if (tl + 16 < NT32) IDX_TILE(kb2, tl + 16);
        }
        }
#undef IDX_TILE
#undef IDX_LOADB
    }
    __syncthreads();
    for (int rse_ = 0; rse_ < REP_SEL; ++rse_) {
        const int t = t0 + wave;
        const LAS float* Sr = S + wave * SSTR;
        unsigned long long* brow = (unsigned long long*)(BITS + (size_t)(b * LP + t) * BW);
        if (t < 256) {
            for (int j = 0; j < nj; ++j) { const unsigned long long mk = __ballot((64 * j + lane) <= t); if (lane == 0) brow[j] = mk; }
        } else {
            const LAS unsigned* H = HIST + wave * 512;
            const u32x4 ha = *(const LAS u32x4*)(H + 8 * lane), hb = *(const LAS u32x4*)(H + 8 * lane + 4);
            const unsigned lsum = (ha.x + ha.y) + (ha.z + ha.w) + (hb.x + hb.y) + (hb.z + hb.w);
            unsigned incl = lsum;
#pragma unroll
            for (int o = 1; o < 64; o <<= 1) { const unsigned v = __shfl_down(incl, o); if (lane + o < 64) incl += v; }
            unsigned cum = incl - lsum; int Bsel = -1; unsigned cab = 0u;
#define P2_STEP(hv, i) do { if (Bsel < 0 && cum < 256u && cum + (hv) >= 256u) { Bsel = 8 * lane + (i); cab = cum; } cum += (hv); } while (0)
            P2_STEP(hb.w, 7); P2_STEP(hb.z, 6); P2_STEP(hb.y, 5); P2_STEP(hb.x, 4); P2_STEP(ha.w, 3); P2_STEP(ha.z, 2); P2_STEP(ha.y, 1); P2_STEP(ha.x, 0);
#undef P2_STEP
            const unsigned long long fm = __ballot(Bsel >= 0);
            const int src = (int)__ffsll((unsigned long long)fm) - 1;
            const int Bb = __builtin_amdgcn_readlane(Bsel, src);
            const int c_above = __builtin_amdgcn_readlane((int)cab, src);
            const int cB = (int)H[Bb];
            const int rr = 256 - c_above;
            if (fm == 0ull || cB > 64 || rr < 1 || rr > cB) {
                select_bisect(Sr, brow, nj, lane);
            } else {
                const float rs = RS[wave];
                const float hiT = (Bb >= 511) ? INFINITY : (float)(Bb + 1), loT = (Bb <= 0) ? -INFINITY : (float)Bb;
                const int jt = t >> 6; const unsigned long long tailm = (~0ull) >> (63 - (t & 63));
                unsigned long long w0 = 0ull, w1 = 0ull;
                int cnt = 0;
#define SEL_CHUNK(fv, j, vm) do { \
                        const float vv = __builtin_fmaf((fv), rs, 256.0f); \
                        const unsigned long long mh = __ballot(vv >= hiT) & (vm); \
                        const unsigned long long mc = __ballot(vv >= loT) & (vm) & ~mh; \
                        if (lane == ((j) & 63)) { if ((j) < 64) w0 = mh; else w1 = mh; } \
                        if (mc != 0ull) { \
                            const bool is = (mc >> lane) & 1ull; \
                            const int pos = cnt + (int)__builtin_amdgcn_mbcnt_hi((unsigned)(mc >> 32), __builtin_amdgcn_mbcnt_lo((unsigned)mc, 0u)); \
                            if (is && pos < 64) { CAND[wave * 64 + pos] = ord_key(fv); CIDX[wave * 64 + pos] = (unsigned)(64 * (j) + lane); } \
                            cnt += __popcll(mc); \
                        } } while (0)
                int j0 = 0;
                for (; j0 + 4 <= jt; j0 += 4) {
                    float f4[4];
#pragma unroll
                    for (int i = 0; i < 4; ++i) f4[i] = Sr[64 * (j0 + i) + lane];
#pragma unroll
                    for (int i = 0; i < 4; ++i) SEL_CHUNK(f4[i], j0 + i, ~0ull);
                }
                for (; j0 <= jt; ++j0) {
                    const float f1 = Sr[64 * j0 + lane];
                    const unsigned long long vm = (j0 < jt) ? ~0ull : tailm;
                    SEL_CHUNK(f1, j0, vm);
                }
#undef SEL_CHUNK
                asm volatile("s_waitcnt lgkmcnt(0)" ::: "memory");
                const unsigned myk = (lane < cB) ? CAND[wave * 64 + lane] : 0u;
                const unsigned myi = (lane < cB) ? CIDX[wave * 64 + lane] : 0u;
                int rank = 0;
                for (int jj = 0; jj < cB; ++jj) { const unsigned kj = (unsigned)__builtin_amdgcn_readlane((int)myk, jj); rank += ((kj > myk) || (kj == myk && jj < lane)) ? 1 : 0; }
                unsigned long long chosen = __ballot(lane < cB && rank < rr);
                while (chosen != 0ull) {
                    const int c = (int)__ffsll((unsigned long long)chosen) - 1; chosen &= chosen - 1ull;
                    const unsigned ci = (unsigned)__builtin_amdgcn_readlane((int)myi, c);
                    const int jc = (int)(ci >> 6); const unsigned long long bit = 1ull << (ci & 63u);
                    if (lane == (jc & 63)) { if (jc < 64) w0 |= bit; else w1 |= bit; }
                }
                if (lane < nj) brow[lane] = w0;
                if (lane < 2 && 64 + lane < nj) brow[64 + lane] = w1;
            }
        }
    }
    __syncthreads();
}

__device__ __forceinline__ void conv_tile(int b, int ti, const bf16_t* U, const bf16_t* ZC, const float* cw, const float* cb, const float* lg, const float* lb,
                                          bf16_t* YMIX, LAS float* C, int tid, int wave, int lane) {
    const int t0 = 32 * ti;
    {
        const int cp = tid & 255, rh = tid >> 8;
        float w0[31], w1[31];
#pragma unroll
        for (int j = 0; j < 31; ++j) { const f32x2 ww = *(const f32x2*)(cw + j * 512 + 2 * cp); w0[j] = ww[0]; w1[j] = ww[1]; }
        const f32x2 bias = *(const f32x2*)(cb + 2 * cp);
        float x0[46], x1[46];
#pragma unroll
        for (int i = 0; i < 46; ++i) { const int t = t0 - 30 + 16 * rh + i; x0[i] = 0.f; x1[i] = 0.f;
            if (t >= 0) { const unsigned pu = *(const unsigned*)(U + (size_t)(b * LP + t) * 512 + 2 * cp); x0[i] = bflo(pu); x1[i] = bfhi(pu); } }
#pragma unroll
        for (int o = 0; o < 16; ++o) { float a0 = bias[0], a1 = bias[1];
#pragma unroll
            for (int j = 0; j < 31; ++j) { a0 = fmaf(w0[j], x0[o + j], a0); a1 = fmaf(w1[j], x1[o + j], a1); }
            f32x2 r2; r2[0] = a0; r2[1] = a1; *(LAS f32x2*)(C + (16 * rh + o) * 512 + 2 * cp) = r2; }
    }
    const f32x4 g0 = *(const f32x4*)(lg + lane * 8), g1 = *(const f32x4*)(lg + lane * 8 + 4), b0 = *(const f32x4*)(lb + lane * 8), b1 = *(const f32x4*)(lb + lane * 8 + 4);
    u32x4 zz[4];
#pragma unroll
    for (int rr = 0; rr < 4; ++rr) zz[rr] = *(const u32x4*)(ZC + (size_t)(b * LP + t0 + 4 * wave + rr) * 512 + lane * 8);
    asm volatile("s_waitcnt lgkmcnt(0)\n\ts_barrier" ::: "memory");
    {
        f32x4 a0[4], a1[4]; float sm[4], sq[4];
#pragma unroll
        for (int rr = 0; rr < 4; ++rr) { const LAS float* cr = C + (4 * wave + rr) * 512 + lane * 8; a0[rr] = *(const LAS f32x4*)cr; a1[rr] = *(const LAS f32x4*)(cr + 4);
            sm[rr] = (a0[rr][0] + a0[rr][1]) + (a0[rr][2] + a0[rr][3]) + (a1[rr][0] + a1[rr][1]) + (a1[rr][2] + a1[rr][3]); }
#pragma unroll
        for (int o = 1; o < 64; o <<= 1) {
#pragma unroll
            for (int rr = 0; rr < 4; ++rr) sm[rr] += __shfl_xor(sm[rr], o); }
#pragma unroll
        for (int rr = 0; rr < 4; ++rr) { const float mean = sm[rr] * (1.f / 512.f); a0[rr] = a0[rr] - mean; a1[rr] = a1[rr] - mean;
            sq[rr] = (a0[rr][0] * a0[rr][0] + a0[rr][1] * a0[rr][1]) + (a0[rr][2] * a0[rr][2] + a0[rr][3] * a0[rr][3]) + (a1[rr][0] * a1[rr][0] + a1[rr][1] * a1[rr][1]) + (a1[rr][2] * a1[rr][2] + a1[rr][3] * a1[rr][3]); }
#pragma unroll
        for (int o = 1; o < 64; o <<= 1) {
#pragma unroll
            for (int rr = 0; rr < 4; ++rr) sq[rr] += __shfl_xor(sq[rr], o); }
#pragma unroll
        for (int rr = 0; rr < 4; ++rr) {
            const float rstd = 1.0f / sqrtf(sq[rr] * (1.f / 512.f) + LN_EPS);
            const size_t row = (size_t)(b * LP + t0 + 4 * wave + rr);
            const u32x4 z = zz[rr];
            const f32x4 y0 = a0[rr] * rstd * g0 + b0, y1 = a1[rr] * rstd * g1 + b1;
            u32x4 w;
            w.x = pk2(y0[0] * sigmoidf_(y0[0]) * bflo(z.x), y0[1] * sigmoidf_(y0[1]) * bfhi(z.x));
            w.y = pk2(y0[2] * sigmoidf_(y0[2]) * bflo(z.y), y0[3] * sigmoidf_(y0[3]) * bfhi(z.y));
            w.z = pk2(y1[0] * sigmoidf_(y1[0]) * bflo(z.z), y1[1] * sigmoidf_(y1[1]) * bfhi(z.z));
            w.w = pk2(y1[2] * sigmoidf_(y1[2]) * bflo(z.w), y1[3] * sigmoidf_(y1[3]) * bfhi(z.w));
            *(u32x4*)(YMIX + row * 1024 + lane * 8) = w;
        }
    }
    asm volatile("s_waitcnt lgkmcnt(0)\n\ts_barrier" ::: "memory");
}

constexpr int KSTR = 272, VSTR = 320;
typedef short v4i16_t __attribute__((ext_vector_type(4)));
__device__ __forceinline__ float vmax3(float a, float b, float c) { float r; asm("v_max3_f32 %0, %1, %2, %3" : "=v"(r) : "v"(a), "v"(b), "v"(c)); return r; }
#define bfe1(w, c) ({ unsigned m_; asm("v_bfe_i32 %0, %1, %2, 1" : "=v"(m_) : "v"(w), "n"(c)); m_; })
__device__ __forceinline__ void attn_unit(int b, int hp, int qb, const bf16_t* Q, const bf16_t* K, const bf16_t* V, const bf16_t* ZA, const unsigned* BITS, bf16_t* YMIX,
                                          LAS unsigned char* lds, int tid, int wave, int lane) {
    const int hl = wave >> 2, h = 2 * hp + hl;
    const int q0 = 128 * qb, qw0 = q0 + 32 * (wave & 3);
    const int n = lane & 31, hh = lane >> 5;
    const size_t qrow = (size_t)(b * LP + qw0 + n);
    bf16x8 qf[4];
#pragma unroll
    for (int ks = 0; ks < 4; ++ks) qf[ks] = *(const bf16x8*)(Q + qrow * 512 + h * 64 + ks * 16 + hh * 8);
    const int NT = 2 * qb + 2;
    LAS unsigned char* Ks = lds; LAS unsigned char* Vs = lds + 2 * 64 * KSTR;
    const int r0 = tid >> 4, ch = tid & 15;
    const size_t gb = (size_t)(b * LP) * 512 + hp * 128 + ch * 8;
    u32x4 kA0, kA1, vA0, vA1, kB0, kB1, vB0, vB1;
#define ATT_LOAD(tile, k0, k1, v0, v1) do { const size_t ro = gb + (size_t)(64 * (tile) + r0) * 512; k0 = *(const u32x4*)(K + ro); k1 = *(const u32x4*)(K + ro + 32 * 512); v0 = *(const u32x4*)(V + ro); v1 = *(const u32x4*)(V + ro + 32 * 512); } while (0)
#define ATT_STORE(buf, k0, k1, v0, v1) do { *(LAS u32x4*)(Ks + (buf) * 64 * KSTR + r0 * KSTR + ch * 16) = k0; *(LAS u32x4*)(Ks + (buf) * 64 * KSTR + (r0 + 32) * KSTR + ch * 16) = k1; \
        *(LAS u32x4*)(Vs + (buf) * 64 * VSTR + r0 * VSTR + ch * 16) = v0; *(LAS u32x4*)(Vs + (buf) * 64 * VSTR + (r0 + 32) * VSTR + ch * 16) = v1; } while (0)
#define ATT_BAR() asm volatile("s_waitcnt lgkmcnt(0)\n\ts_barrier" ::: "memory")
    const unsigned long long* mrow = (const unsigned long long*)(BITS + qrow * BW);
    ATT_LOAD(0, kA0, kA1, vA0, vA1); ATT_LOAD(1, kB0, kB1, vB0, vB1);
    ATT_STORE(0, kA0, kA1, vA0, vA1);
    if (NT > 2) ATT_LOAD(2, kA0, kA1, vA0, vA1);
    unsigned long long mwA = mrow[0], mwB = mrow[1];
    ATT_BAR();
    float mrun = 0.f, lrun = 0.f; f32x16 o0 = {}, o1 = {}, negm = {};
    const int qq4 = (lane & 15) >> 2, pp = lane & 3, blk = (lane >> 4) & 1;
    for (int tile2 = 0; tile2 < NT; tile2 += 2) {
#pragma unroll
        for (int half = 0; half < 2; ++half) {
            const int tile = tile2 + half; const int buf = half;
            const unsigned long long mw = half ? mwB : mwA;
            if (64 * tile <= qw0 + 31 && qw0 < LV) {
            f32x16 s0 = negm, s1 = negm;
            const LAS unsigned char* kb = Ks + buf * 64 * KSTR + n * KSTR + hl * 128 + hh * 16;
            bf16x8 kf0[4], kf1[4];
#pragma unroll
            for (int ks = 0; ks < 4; ++ks) { kf0[ks] = *(const LAS bf16x8*)(kb + ks * 32); kf1[ks] = *(const LAS bf16x8*)(kb + 32 * KSTR + ks * 32); }
            __builtin_amdgcn_sched_barrier(0);
#pragma unroll
            for (int ks = 0; ks < 4; ++ks) {
                s0 = __builtin_amdgcn_mfma_f32_32x32x16_bf16(kf0[ks], qf[ks], s0, 0, 0, 0);
                s1 = __builtin_amdgcn_mfma_f32_32x32x16_bf16(kf1[ks], qf[ks], s1, 0, 0, 0);
            }
            const LAS unsigned char* vb = Vs + buf * 64 * VSTR + (4 * hh + qq4) * VSTR + (hl * 64 + 16 * blk + 4 * pp) * 2;
            s16x4 vlo[2][2][2], vhi[2][2][2];
#pragma unroll
            for (int mb = 0; mb < 2; ++mb)
#pragma unroll
                for (int ks = 0; ks < 2; ++ks)
#pragma unroll
                    for (int db = 0; db < 2; ++db) {
                        const LAS unsigned char* vk = vb + (32 * mb + 16 * ks) * VSTR;
                        vlo[mb][ks][db] = __builtin_bit_cast(s16x4, __builtin_amdgcn_ds_read_tr16_b64_v4i16((LAS v4i16_t*)(vk + db * 64)));
                        vhi[mb][ks][db] = __builtin_bit_cast(s16x4, __builtin_amdgcn_ds_read_tr16_b64_v4i16((LAS v4i16_t*)(vk + 8 * VSTR + db * 64)));
                    }
            __builtin_amdgcn_sched_barrier(0);
            float mxa = fmaxf(s0[0], s1[0]), mxb = fmaxf(s0[1], s1[1]);
#pragma unroll
            for (int r = 2; r < 16; r += 2) { mxa = vmax3(mxa, s0[r], s1[r]); mxb = vmax3(mxb, s0[r + 1], s1[r + 1]); }
            float mx = fmaxf(mxa, mxb);
            if (__any(mx > 6.0f)) {
                mx = fmaxf(mx, __shfl_xor(mx, 32));
                const float dl = fmaxf(mx, 0.f);
                mrun += dl;
                const float alpha = __builtin_amdgcn_exp2f(-dl);
                lrun *= alpha;
#pragma unroll
                for (int r = 0; r < 16; ++r) { s0[r] -= dl; s1[r] -= dl; o0[r] *= alpha; o1[r] *= alpha; negm[r] = -mrun; }
            }
            const int wl = (int)((unsigned)mw >> (4 * hh)), wh = (int)((unsigned)(mw >> 32) >> (4 * hh));
            float psa = 0.f, psb = 0.f, psc = 0.f, psd = 0.f;
#pragma unroll
            for (int r = 0; r < 16; r += 2) {
                const int c0b = (r & 3) + 8 * (r >> 2), c1b = ((r + 1) & 3) + 8 * ((r + 1) >> 2);
                const float a0 = __uint_as_float(__float_as_uint(__builtin_amdgcn_exp2f(s0[r])) & bfe1(wl, c0b));
                const float a1 = __uint_as_float(__float_as_uint(__builtin_amdgcn_exp2f(s0[r + 1])) & bfe1(wl, c1b));
                const float b0 = __uint_as_float(__float_as_uint(__builtin_amdgcn_exp2f(s1[r])) & bfe1(wh, c0b));
                const float b1 = __uint_as_float(__float_as_uint(__builtin_amdgcn_exp2f(s1[r + 1])) & bfe1(wh, c1b));
                s0[r] = a0; s0[r + 1] = a1; s1[r] = b0; s1[r + 1] = b1;
                psa += a0; psb += a1; psc += b0; psd += b1; asm volatile("" : "+v"(psa), "+v"(psb), "+v"(psc), "+v"(psd));
            }
            lrun += (psa + psb) + (psc + psd);
            __builtin_amdgcn_sched_barrier(0);
#pragma unroll
            for (int mb = 0; mb < 2; ++mb)
#pragma unroll
                for (int ks = 0; ks < 2; ++ks) {
                    bf16x8 pf;
                    { u32x4 pw;
                      if (mb == 0) { pw.x = pk2(s0[8 * ks + 0], s0[8 * ks + 1]); pw.y = pk2(s0[8 * ks + 2], s0[8 * ks + 3]); pw.z = pk2(s0[8 * ks + 4], s0[8 * ks + 5]); pw.w = pk2(s0[8 * ks + 6], s0[8 * ks + 7]); }
                      else         { pw.x = pk2(s1[8 * ks + 0], s1[8 * ks + 1]); pw.y = pk2(s1[8 * ks + 2], s1[8 * ks + 3]); pw.z = pk2(s1[8 * ks + 4], s1[8 * ks + 5]); pw.w = pk2(s1[8 * ks + 6], s1[8 * ks + 7]); }
                      pf = __builtin_bit_cast(bf16x8, pw); }
#pragma unroll
                    for (int db = 0; db < 2; ++db) {
                        const s16x4 lo = vlo[mb][ks][db], hi = vhi[mb][ks][db];
                        const bf16x8 vf = (bf16x8){lo[0], lo[1], lo[2], lo[3], hi[0], hi[1], hi[2], hi[3]};
                        if (db == 0) o0 = __builtin_amdgcn_mfma_f32_32x32x16_bf16(vf, pf, o0, 0, 0, 0);
                        else         o1 = __builtin_amdgcn_mfma_f32_32x32x16_bf16(vf, pf, o1, 0, 0, 0);
                    }
                }
            }
            if (half == 0) {
                ATT_STORE(1, kB0, kB1, vB0, vB1);
                if (tile + 3 < NT) ATT_LOAD(tile + 3, kB0, kB1, vB0, vB1);
                if (tile + 2 < NT) mwA = mrow[tile + 2];
            } else {
                if (tile + 1 < NT) { ATT_STORE(0, kA0, kA1, vA0, vA1); if (tile + 3 < NT) ATT_LOAD(tile + 3, kA0, kA1, vA0, vA1); }
                if (tile + 2 < NT) mwB = mrow[tile + 2];
            }
            ATT_BAR();
        }
    }
#undef ATT_LOAD
#undef ATT_STORE
#undef ATT_BAR
    lrun += __shfl_xor(lrun, 32);
    const float inv = 1.0f / lrun;
#pragma unroll
    for (int db = 0; db < 2; ++db)
#pragma unroll
        for (int g4 = 0; g4 < 4; ++g4) {
            const int d0 = 32 * db + 8 * g4 + 4 * hh;
            const u32x2 z = *(const u32x2*)(ZA + qrow * 512 + h * 64 + d0);
            float v0, v1, v2, v3;
            if (db == 0) { v0 = o0[4 * g4]; v1 = o0[4 * g4 + 1]; v2 = o0[4 * g4 + 2]; v3 = o0[4 * g4 + 3]; } else { v0 = o1[4 * g4]; v1 = o1[4 * g4 + 1]; v2 = o1[4 * g4 + 2]; v3 = o1[4 * g4 + 3]; }
            u32x2 w; w.x = pk2(v0 * inv * bflo(z.x), v1 * inv * bfhi(z.x)); w.y = pk2(v2 * inv * bflo(z.y), v3 * inv * bfhi(z.y));
            *(u32x2*)(YMIX + qrow * 1024 + 512 + h * 64 + d0) = w;
        }
}

__device__ __forceinline__ void ln_phase(const Params& p, int l, int wave, int lane) {
    const int gw = blockIdx.x * 8 + wave, NGW = gridDim.x * 8;
    bf16_t* HB = (bf16_t*)(p.ws + WS_HB); float* METAH = (float*)(p.ws + WS_METAH);
    const float* G = p.post_g + l * 1024; const float* Bv = p.post_b + l * 1024;
    f32x4 gg[4], bb[4];
#pragma unroll
    for (int j = 0; j < 4; ++j) { gg[j] = *((const f32x4*)G + lane + 64 * j); bb[j] = *((const f32x4*)Bv + lane + 64 * j); }
    constexpr int NGRP = NB * LV / 4;
    for (int g = gw; g < NGRP; g += NGW) {
        const int v0 = 4 * g; const int b = v0 / LV, t0 = v0 - b * LV;
        float* hp[4]; f32x4 v[4][4]; float s[4], q[4];
#pragma unroll
        for (int i = 0; i < 4; ++i) { const int t = t0 + i; hp[i] = (t < NMETA) ? (METAH + (size_t)(b * NMETA + t) * 1024) : (p.out + ((size_t)b * SEQ + (t - NMETA)) * 1024); }
#pragma unroll
        for (int i = 0; i < 4; ++i) { s[i] = 0.f;
#pragma unroll
            for (int j = 0; j < 4; ++j) { v[i][j] = *((const f32x4*)hp[i] + lane + 64 * j); } }
#pragma unroll
        for (int i = 0; i < 4; ++i)
#pragma unroll
            for (int j = 0; j < 4; ++j) s[i] += (v[i][j][0] + v[i][j][1]) + (v[i][j][2] + v[i][j][3]);
#pragma unroll
        for (int o = 1; o < 64; o <<= 1) {
#pragma unroll
            for (int i = 0; i < 4; ++i) s[i] += __shfl_xor(s[i], o); }
#pragma unroll
        for (int i = 0; i < 4; ++i) { const float mean = s[i] * (1.f / 1024.f); s[i] = mean; q[i] = 0.f;
#pragma unroll
            for (int j = 0; j < 4; ++j) { v[i][j] = v[i][j] - mean; q[i] += (v[i][j][0] * v[i][j][0] + v[i][j][1] * v[i][j][1]) + (v[i][j][2] * v[i][j][2] + v[i][j][3] * v[i][j][3]); } }
#pragma unroll
        for (int o = 1; o < 64; o <<= 1) {
#pragma unroll
            for (int i = 0; i < 4; ++i) q[i] += __shfl_xor(q[i], o); }
#pragma unroll
        for (int i = 0; i < 4; ++i) {
            const float rstd = 1.0f / sqrtf(q[i] * (1.f / 1024.f) + LN_EPS);
            const size_t r = (size_t)(b * LP + t0 + i);
            u32x2* o = (u32x2*)(HB + r * 1024) + lane;
            if (lane == 0) { f32x2 st; st[0] = s[i]; st[1] = rstd; *(f32x2*)((float*)(p.ws + WS_STAT) + r * 2) = st; }
#pragma unroll
            for (int j = 0; j < 4; ++j) { const f32x4 y = v[i][j] * rstd * gg[j] + bb[j]; if (l == DEPTH - 1) *((f32x4*)hp[i] + lane + 64 * j) = y;
                u32x2 w; w.x = pk2(y[0], y[1]); w.y = pk2(y[2], y[3]); o[64 * j] = w; }
        }
    }
}

#define XB_TMO      128
#define XB_XCNT(j)  (256  + 64 * (j))
#define XB_XSUB(j)  (1280 + 64 * (j))
#define XB_XGEN(j)  (2304 + 64 * (j))
#define XB_TOP      3328
#define XB_TOPGEN   3392
#define XCD_BAR_WORDS 3456
#define XB_SPIN_CAP (1u << 18)

__device__ __forceinline__ unsigned xb_ld(unsigned* p)              { return __hip_atomic_load(p, __ATOMIC_RELAXED, __HIP_MEMORY_SCOPE_AGENT); }
__device__ __forceinline__ unsigned xb_add(unsigned* p, unsigned v) { return __hip_atomic_fetch_add(p, v, __ATOMIC_RELAXED, __HIP_MEMORY_SCOPE_AGENT); }
__device__ __forceinline__ unsigned xb_xcc_id() { return (unsigned)__builtin_amdgcn_s_getreg((3 << 11) | 20) & 0xFu; }
#define XB_SPIN(cond, bar) do { unsigned _sp = 0; while (cond) { __builtin_amdgcn_s_sleep(1); \
    if ((++_sp & 255u) == 0u) { if (xb_ld(&(bar)[XB_TMO])) break; if (_sp > XB_SPIN_CAP) { atomicAdd(&(bar)[XB_TMO], 1u); break; } } } } while (0)

struct XcdBarrier {
    unsigned* bar; unsigned x;
    volatile LAS unsigned* st;
};

__device__ __forceinline__ XcdBarrier xcd_barrier_post(unsigned* bar, volatile LAS unsigned* st) {
    XcdBarrier b; b.bar = bar; b.x = xb_xcc_id(); b.st = st;
    if (threadIdx.x == 0) (void)xb_add(&bar[XB_XCNT(b.x)], 1u);
    return b;
}
__device__ __forceinline__ void xcd_barrier_complete(unsigned* bar, unsigned x, unsigned& nloc, unsigned& nx) {
    const unsigned G = gridDim.x * gridDim.y * gridDim.z;
    unsigned sum, cnt, mine, sp = 0u;
    for (;;) {
        sum = 0u; cnt = 0u; mine = 0u;
#pragma unroll
        for (unsigned j = 0; j < 16; ++j) { const unsigned c = xb_ld(&bar[XB_XCNT(j)]); sum += c; cnt += (c > 0u) ? 1u : 0u; mine = (j == x) ? c : mine; }
        if (sum == G) break;
        __builtin_amdgcn_s_sleep(1);
        if ((++sp & 255u) == 0u) { if (xb_ld(&bar[XB_TMO])) break; if (sp > XB_SPIN_CAP) { atomicAdd(&bar[XB_TMO], 1u); break; } }
    }
    nloc = mine > 0u ? mine : 1u; nx = cnt > 0u ? cnt : 1u;
}

__device__ __forceinline__ void xcd_barrier(const XcdBarrier& b) {
    asm volatile("s_waitcnt vmcnt(0)" ::: "memory");
    __syncthreads();
    if (threadIdx.x == 0) {
        unsigned* bar = b.bar;
        __builtin_amdgcn_s_waitcnt(0);
        unsigned nloc = b.st[0], nx = b.st[1];
        if (nloc == 0u) { xcd_barrier_complete(bar, b.x, nloc, nx); b.st[0] = nloc; b.st[1] = nx; }
        const unsigned old = xb_add(&bar[XB_XSUB(b.x)], 1u);
        const unsigned gen = old / nloc;
        if (old + 1u == (gen + 1u) * nloc) {
            __builtin_amdgcn_fence(__ATOMIC_RELEASE, "agent");
            asm volatile("s_waitcnt vmcnt(0)" ::: "memory");
            const unsigned og = xb_add(&bar[XB_TOP], 1u);
            const unsigned tg = og / nx;
            if (og + 1u == (tg + 1u) * nx) xb_add(&bar[XB_TOPGEN], 1u);
            else XB_SPIN(xb_ld(&bar[XB_TOPGEN]) == tg, bar);
            __builtin_amdgcn_fence(__ATOMIC_ACQUIRE, "agent");
            xb_add(&bar[XB_XGEN(b.x)], 1u);
            asm volatile("s_waitcnt vmcnt(0)" ::: "memory");
        } else {
            XB_SPIN(xb_ld(&bar[XB_XGEN(b.x)]) == gen, bar);
            __builtin_amdgcn_fence(__ATOMIC_ACQUIRE, "agent");
            asm volatile("s_waitcnt vmcnt(0)" ::: "memory");
        }
    }
    __syncthreads();
}

#ifndef REP_P2
#define REP_P2 1
#endif
#ifndef REP_IDX
#define REP_IDX 1
#endif
#ifndef REP_CONV
#define REP_CONV 1
#endif
#ifndef REP_P0
#define REP_P0 1
#endif
#ifndef REP_SYNC
#define REP_SYNC 0
#endif
#ifndef REP_P3
#define REP_P3 1
#endif
#ifndef REP_G1
#define REP_G1 1
#endif
__global__ void __launch_bounds__(512, 2) fwd_megakernel(Params p) {
    extern __shared__ __attribute__((aligned(16))) unsigned char lds_raw[];
    cg::grid_group grid = cg::this_grid();
    LAS unsigned char* lds = (LAS unsigned char*)lds_raw;
    const int tid = threadIdx.x, lane = tid & 63, wave = __builtin_amdgcn_readfirstlane(tid >> 6);
    const int G = gridDim.x, bx = blockIdx.x;
    unsigned char* ws = p.ws;
    bf16_t* HB = (bf16_t*)(ws + WS_HB);
    bf16_t *U = (bf16_t*)(ws + WS_U), *ZC = (bf16_t*)(ws + WS_ZC), *Q = (bf16_t*)(ws + WS_Q), *K = (bf16_t*)(ws + WS_K), *V = (bf16_t*)(ws + WS_V),
           *ZA = (bf16_t*)(ws + WS_ZA), *QI = (bf16_t*)(ws + WS_QI), *KI = (bf16_t*)(ws + WS_KI), *YMIX = (bf16_t*)(ws + WS_YMIX);
    float* WI = (float*)(ws + WS_WI); unsigned* BITS = (unsigned*)(ws + WS_BITS); float* METAH = (float*)(ws + WS_METAH);
    const float* cosT = (const float*)(ws + WS_COS); const float* sinT = (const float*)(ws + WS_SIN);

    if (tid < 16) ((LAS unsigned*)(lds + LDS_BYTES - 64))[tid] = 0u;
    if (bx == 0) { for (int i = tid; i < XCD_BAR_WORDS; i += 512) ((unsigned*)(ws + WS_BAR))[i] = 0u; __threadfence(); }
    __syncthreads();
#ifndef NO_P0
    for (int rp_ = 0; rp_ < REP_P0; ++rp_) p0_prologue(p, lds, wave, lane);
#endif
    grid.sync();
    const XcdBarrier xbar = xcd_barrier_post((unsigned*)(ws + WS_BAR), (volatile LAS unsigned*)(lds + LDS_BYTES - 64));
#define GSYNC() xcd_barrier(xbar)
    for (int rs_ = 0; rs_ < REP_SYNC; ++rs_) GSYNC();

#define LAUNDER() int tid_ = tid, wave_ = wave; asm volatile("" : "+v"(tid_)); asm volatile("" : "+s"(wave_)); const int lane_ = tid_ & 63; (void)lane_; (void)wave_
#pragma unroll 1
    for (int l = 0; l < DEPTH; ++l) {
#ifndef NO_G1
        for (int rep_ = 0; rep_ < REP_G1; ++rep_) {
            pg8::Gemm g{HB, (const bf16_t*)(ws + WS_WIN) + (size_t)l * NPAD * 1024, NR, NPAD, 1024};
            pg8::StaticOrder S; S.init(NR, NPAD, G, bx);
            EpiIn E{U, ZC, Q, K, V, ZA, QI, KI, WI, cosT, sinT};
            pg8::gemm_phase<EpiIn, pg8::StaticOrder, true, true>(lds, g, S, E);
        }
#endif
        GSYNC();
#ifndef NO_P2
        for (int rep_ = 0; rep_ < REP_P2; ++rep_) {
            LAUNDER();
            constexpr int NITEM = NB * (LV / 8);
            for (int ri_ = 0; ri_ < REP_IDX; ++ri_)
            for (int k = 0; k * G < NITEM; ++k) {
                const int idx = (k & 1) ? (k * G + (G - 1 - bx)) : (k * G + bx);
                if (idx < NITEM) { const int g = (LV / 8 - 1) - idx / NB, b = idx % NB; idx_item(b, g, QI, KI, WI, BITS, lds, tid_, wave_, lane_); }
            }
            constexpr int NCT = NB * (LP / 32);
            for (int rc_ = 0; rc_ < REP_CONV; ++rc_)
            for (int ct = (G - 1 - bx); ct < NCT; ct += G) {
                const int b = ct / (LP / 32), ti = ct - b * (LP / 32);
                if (32 * ti >= LV) continue;
                conv_tile(b, ti, U, ZC, p.conv_w + (size_t)l * 31 * 512, p.conv_b + l * 512, p.conv_ln_g + l * 512, p.conv_ln_b + l * 512, YMIX, (LAS float*)lds, tid_, wave_, lane_);
            }
        }
#endif
        GSYNC();
#ifndef NO_P3
        for (int rep_ = 0; rep_ < REP_P3; ++rep_) {
            LAUNDER();
            constexpr int NU = NB * 4 * (LP / 128);
            for (int k = 0; k * G < NU; ++k) {
                const int idx = (k & 1) ? (k * G + (G - 1 - bx)) : (k * G + bx);
                if (idx < NU) { const int qb = (LP / 128 - 1) - idx / 32, bh = idx % 32; attn_unit(bh >> 2, bh & 3, qb, Q, K, V, ZA, BITS, YMIX, lds, tid_, wave_, lane_); }
            }
        }
#endif
        GSYNC();
#ifndef NO_G2
        {
            pg8::Gemm g{YMIX, (const bf16_t*)(ws + WS_WOUT) + (size_t)l * 1024 * 1024, NR, 1024, 1024};
            pg8::StaticOrder S; S.init(NR, 1024, G, bx);
            EpiOut E{l == 0 ? p.x : p.out, l == 0 ? p.meta : METAH, l == 0 ? 0 : NMETA * 1024, p.out, METAH,
                     l == 0 ? (const float*)nullptr : (const float*)(ws + WS_STAT), p.post_g + (l > 0 ? l - 1 : 0) * 1024, p.post_b + (l > 0 ? l - 1 : 0) * 1024, (float*)(ws + WS_DUMP)};
            pg8::gemm_phase<EpiOut, pg8::StaticOrder, true, true>(lds, g, S, E);
        }
#endif
        GSYNC();
#ifndef NO_P4
        { LAUNDER(); ln_phase(p, l, wave_, lane_); }
#endif
        GSYNC();
    }
}

extern "C" void kernel_launch(void* const* d_in, const int* in_sizes, int n_in, void* d_out, int out_size, void* d_ws, size_t ws_size, hipStream_t stream) {
    static int grid_blocks = 0;
    if (grid_blocks == 0) {
        if (ws_size < WS_END) { fprintf(stderr, "kernel_launch: workspace too small: %zu < %zu\n", ws_size, (size_t)WS_END); grid_blocks = -1; return; }
        int dev = 0, cus = 0, per_cu = 0;
        hipGetDevice(&dev);
        hipDeviceGetAttribute(&cus, hipDeviceAttributeMultiprocessorCount, dev);
        if (hipFuncSetAttribute((const void*)fwd_megakernel, hipFuncAttributeMaxDynamicSharedMemorySize, LDS_BYTES) != hipSuccess) { fprintf(stderr, "kernel_launch: hipFuncSetAttribute failed\n"); }
        if (hipOccupancyMaxActiveBlocksPerMultiprocessor(&per_cu, (const void*)fwd_megakernel, 512, LDS_BYTES) != hipSuccess || per_cu < 1) { fprintf(stderr, "kernel_launch: occupancy query gave %d\n", per_cu); per_cu = 1; }
        (void)hipGetLastError();
        if (per_cu > 1) per_cu = 1;
        grid_blocks = cus * per_cu;
    }
    if (grid_blocks < 0) return;
    Params p{};
    p.x = (const float*)d_in[0]; p.meta = (const float*)d_in[1]; p.w_in = (const float*)d_in[2]; p.conv_w = (const float*)d_in[3]; p.conv_b = (const float*)d_in[4];
    p.conv_ln_g = (const float*)d_in[5]; p.conv_ln_b = (const float*)d_in[6]; p.w_out = (const float*)d_in[7]; p.post_g = (const float*)d_in[8]; p.post_b = (const float*)d_in[9];
    p.out = (float*)d_out; p.ws = (unsigned char*)d_ws;
    void* args[] = {&p};
    hipError_t e = hipLaunchCooperativeKernel((const void*)fwd_megakernel, dim3(grid_blocks), dim3(512), args, LDS_BYTES, stream);
    if (e != hipSuccess) fprintf(stderr, "cooperative launch failed: %s (grid %d)\n", hipGetErrorString(e), grid_blocks);
}
```

```cpp
#include <hip/hip_runtime.h>
#include <hip/hip_cooperative_groups.h>
#include <cstdio>
#include <cstdint>
namespace cg = cooperative_groups;
namespace pg8 {
#define PG8_LAS __attribute__((address_space(3)))
typedef unsigned short bf16_t;
typedef short bf16x8 __attribute__((ext_vector_type(8)));
typedef float f32x4 __attribute__((ext_vector_type(4)));
typedef unsigned u32x4 __attribute__((ext_vector_type(4)));
constexpr int BM = 256, BK = 64, HALF = 128, HTB = HALF * BK * 2  , STAGE_BYTES = 8 * HTB, NXCD = 8, WGM = 8;

__host__ __device__ __forceinline__ int lds_byte(int r, int c) { const int st = (r >> 4) * 2 + (c >> 5), rr = r & 15, cc = c & 31, ob = rr * 64 + cc * 2; return st * 1024 + (ob ^ (((ob >> 9) & 1) << 5)); }
__host__ __device__ __forceinline__ void stage_rc(int b, int& R, int& C) { const int st = b / 1024, sb = b % 1024, swz = sb ^ (((sb >> 9) & 1) << 5); R = (st >> 1) * 16 + swz / 64; C = (st & 1) * 32 + (swz % 64) / 2; }
__host__ __device__ __forceinline__ int perm32(int rho) { const int n = rho >> 4, i = rho & 15; return 8 * (i >> 2) + 4 * n + (i & 3); }

struct Unit { int pm, pn; };
struct Gemm { const bf16_t* A; const bf16_t* Bt; int M, N, K; };

struct StaticOrder {
    int nM, nN, nwg, G, c;
    __host__ __device__ void init(int M, int N, int G_, int c_) { nM = M / BM; nN = N / BM; nwg = nM * nN; G = G_; c = c_; }
    __host__ __device__ bool next(int i, Unit& u) const {
        const long L = (long)i * G + c; if (L >= nwg) return false;
        int wgid = (int)L; { const int q = nwg / NXCD, r = nwg % NXCD, xcd = wgid % NXCD, off = wgid / NXCD; wgid = (xcd < r ? xcd * (q + 1) : r * (q + 1) + (xcd - r) * q) + off; }
        const int nig = WGM * nN, gid = wgid / nig, fm = gid * WGM, gsz = (nM - fm) < WGM ? (nM - fm) : WGM;
        u.pm = fm + ((wgid % nig) % gsz); u.pn = (wgid % nig) / gsz; return true;
    }
    __device__ __forceinline__ void a_ready(const Unit&) const {}
    __device__ __forceinline__ void done(const Unit&) const {}
};
template <class Epi, class Sched, bool ALIGN_EPI = false, bool SP2 = false>
__device__ __forceinline__ void gemm_phase(PG8_LAS unsigned char* lds, const Gemm g, const Sched& S, const Epi& E) {
    int tid = threadIdx.x; asm volatile("" : "+v"(tid)); const int wid = __builtin_amdgcn_readfirstlane(tid >> 6), lane = tid & 63, wr = wid >> 2, wc = wid & 3, fr = lane & 15, fq = lane >> 4;
    const int K = g.K, nt = K / BK;
    unsigned voffA[2], voffB[2];
#pragma unroll
    for (int i = 0; i < 2; ++i) { int R, C; stage_rc(tid * 16 + i * 8192, R, C); const int Rb = Epi::PERM ? ((R & ~31) + perm32(R & 31)) : R;
        voffA[i] = (unsigned)(R * K + C) * 2u; voffB[i] = (unsigned)(Rb * K + C) * 2u; }
    const size_t kstep = (size_t)(BK * 2);
    const size_t hstep = (size_t)HALF * K * 2;
    const size_t tstep = 2 * hstep;
    const unsigned ldsw = (unsigned)wid * 1024u;
    const int aoff = lds_byte(wr * 64 + fr, fq * 8), boff = lds_byte(wc * 32 + fr, fq * 8);
#define PG8_SA(b, h) (((b) * 2 + (h)) * HTB)
#define PG8_SB(b, h) ((4 + (b) * 2 + (h)) * HTB)
#define PG8_STAGE(bufoff, gbase, voff) do { _Pragma("unroll") for (int _i = 0; _i < 2; ++_i) \
        __builtin_amdgcn_global_load_lds((const unsigned*)((const char*)(gbase) + (voff)[_i]), (PG8_LAS unsigned*)(lds + (bufoff) + ldsw + _i * 8192), 16, 0, 0); } while (0)
#define PG8_LDA(dst, b, h) do { _Pragma("unroll") for (int m = 0; m < 4; ++m) _Pragma("unroll") for (int k = 0; k < 2; ++k) dst[m][k] = *(const PG8_LAS bf16x8*)(lds + PG8_SA(b, h) + aoff + m * 2048 + k * 1024); } while (0)
#define PG8_LDB(dst, b, h) do { _Pragma("unroll") for (int n = 0; n < 2; ++n) _Pragma("unroll") for (int k = 0; k < 2; ++k) dst[n][k] = *(const PG8_LAS bf16x8*)(lds + PG8_SB(b, h) + boff + n * 2048 + k * 1024); } while (0)
#define PG8_MMA(ai, bj, At, Bt) do { __builtin_amdgcn_s_setprio(1); _Pragma("unroll") for (int m = 0; m < 4; ++m) _Pragma("unroll") for (int n = 0; n < 2; ++n) _Pragma("unroll") for (int k = 0; k < 2; ++k) \
        acc[ai][bj][m][n] = __builtin_amdgcn_mfma_f32_16x16x32_bf16(Bt[n][k], At[m][k], acc[ai][bj][m][n], 0, 0, 0); __builtin_amdgcn_s_setprio(0); } while (0)
#define PG8_WAIT_V(n) asm volatile("s_waitcnt vmcnt(" #n ")" ::: "memory")
#define PG8_WAIT_L(n) asm volatile("s_waitcnt lgkmcnt(" #n ")" ::: "memory")
#define PG8_BAR __builtin_amdgcn_s_barrier()
#define PG8_SCHED __builtin_amdgcn_sched_barrier(0)
    Unit cur, nxt; int ui = 0;
    if (!S.next(0, cur)) return;
    f32x4 acc[2][2][4][2];
#pragma unroll
    for (int a = 0; a < 2; ++a)
#pragma unroll
        for (int b = 0; b < 2; ++b)
#pragma unroll
            for (int m = 0; m < 4; ++m)
#pragma unroll
                for (int n = 0; n < 2; ++n) acc[a][b][m][n] = (f32x4){0.f, 0.f, 0.f, 0.f};
    bf16x8 At[4][2], B0[2][2], B1[2][2];
    const char* cA = (const char*)g.A + (size_t)cur.pm * tstep; const char* cB = (const char*)g.Bt + (size_t)cur.pn * tstep;
    S.a_ready(cur);
    if constexpr (SP2) {
        PG8_STAGE(PG8_SB(0, 0), cB, voffB); PG8_STAGE(PG8_SB(0, 1), cB + hstep, voffB); PG8_STAGE(PG8_SA(0, 0), cA, voffA); PG8_STAGE(PG8_SA(0, 1), cA + hstep, voffA);
        if (wr == 1) PG8_BAR;
        PG8_WAIT_V(2); PG8_BAR;
        PG8_STAGE(PG8_SB(1, 0), cB + kstep, voffB); PG8_STAGE(PG8_SA(1, 0), cA + kstep, voffA); PG8_STAGE(PG8_SB(1, 1), cB + hstep + kstep, voffB);
        PG8_WAIT_V(6); PG8_BAR;
    } else {
        PG8_STAGE(PG8_SB(0, 0), cB, voffB); PG8_STAGE(PG8_SA(0, 0), cA, voffA); PG8_STAGE(PG8_SB(0, 1), cB + hstep, voffB); PG8_STAGE(PG8_SA(0, 1), cA + hstep, voffA);
        if (wr == 1) PG8_BAR;
        PG8_WAIT_V(4); PG8_BAR;
        PG8_STAGE(PG8_SB(1, 0), cB + kstep, voffB); PG8_STAGE(PG8_SA(1, 0), cA + kstep, voffA); PG8_STAGE(PG8_SB(1, 1), cB + hstep + kstep, voffB);
        PG8_WAIT_V(6); PG8_BAR;
    }
    for (;;) {
        const bool has_next = S.next(ui + 1, nxt);
        const char* nA = has_next ? (const char*)g.A + (size_t)nxt.pm * tstep : cA; const char* nB = has_next ? (const char*)g.Bt + (size_t)nxt.pn * tstep : cB;
        for (int t = 0; t < nt; t += 2) {
            const bool last = (t == nt - 2);
            const char* a1 = cA + (size_t)(t + 1) * kstep;
            const char* a2 = last ? nA : cA + (size_t)(t + 2) * kstep; const char* b2 = last ? nB : cB + (size_t)(t + 2) * kstep;
            const char* a3 = a2 + kstep; const char* b3 = b2 + kstep;
            if (last && has_next) S.a_ready(nxt);
            if constexpr (SP2) {
            PG8_LDB(B0, 0, 0); PG8_LDB(B1, 0, 1); PG8_SCHED; PG8_LDA(At, 0, 0); PG8_STAGE(PG8_SA(1, 1), a1 + hstep, voffA);
            PG8_WAIT_V(8); PG8_WAIT_L(0); PG8_BAR; PG8_MMA(0, 0, At, B0); PG8_MMA(0, 1, At, B1); PG8_BAR; PG8_SCHED;
            PG8_LDA(At, 0, 1); PG8_STAGE(PG8_SB(0, 0), b2, voffB); PG8_STAGE(PG8_SB(0, 1), b2 + hstep, voffB); PG8_STAGE(PG8_SA(0, 0), a2, voffA);
            PG8_WAIT_V(8); PG8_WAIT_L(0); PG8_BAR; PG8_MMA(1, 0, At, B0); PG8_MMA(1, 1, At, B1); PG8_BAR; PG8_SCHED;
            PG8_LDB(B0, 1, 0); PG8_LDB(B1, 1, 1); PG8_SCHED; PG8_LDA(At, 1, 0); PG8_STAGE(PG8_SA(0, 1), a2 + hstep, voffA);
            PG8_WAIT_V(8); PG8_WAIT_L(0); PG8_BAR; PG8_MMA(0, 0, At, B0); PG8_MMA(0, 1, At, B1); PG8_BAR; PG8_SCHED;
            PG8_LDA(At, 1, 1); PG8_STAGE(PG8_SB(1, 0), b3, voffB); PG8_STAGE(PG8_SB(1, 1), b3 + hstep, voffB); PG8_STAGE(PG8_SA(1, 0), a3, voffA);
            PG8_WAIT_V(8); PG8_WAIT_L(0); PG8_BAR; PG8_MMA(1, 0, At, B0); PG8_MMA(1, 1, At, B1); PG8_BAR; PG8_SCHED;
            } else {
            PG8_LDB(B0, 0, 0); PG8_SCHED; PG8_LDA(At, 0, 0); PG8_STAGE(PG8_SA(1, 1), a1 + hstep, voffA);
            PG8_WAIT_L(8); PG8_BAR; PG8_WAIT_L(0); PG8_MMA(0, 0, At, B0); PG8_BAR; PG8_SCHED;
            PG8_LDB(B1, 0, 1); PG8_STAGE(PG8_SB(0, 0), b2, voffB);
            PG8_BAR; PG8_WAIT_L(0); PG8_MMA(0, 1, At, B1); PG8_BAR;
            PG8_LDA(At, 0, 1); PG8_STAGE(PG8_SA(0, 0), a2, voffA);
            PG8_BAR; PG8_WAIT_L(0); PG8_MMA(1, 0, At, B0); PG8_BAR; PG8_SCHED;
            PG8_STAGE(PG8_SB(0, 1), b2 + hstep, voffB);
            PG8_WAIT_V(6); PG8_BAR; PG8_MMA(1, 1, At, B1); PG8_BAR;
            PG8_LDB(B0, 1, 0); PG8_SCHED; PG8_LDA(At, 1, 0); PG8_STAGE(PG8_SA(0, 1), a2 + hstep, voffA);
            PG8_WAIT_L(8); PG8_BAR; PG8_WAIT_L(0); PG8_MMA(0, 0, At, B0); PG8_BAR; PG8_SCHED;
            PG8_LDB(B1, 1, 1); PG8_STAGE(PG8_SB(1, 0), b3, voffB);
            PG8_BAR; PG8_WAIT_L(0); PG8_MMA(0, 1, At, B1); PG8_BAR;
            PG8_LDA(At, 1, 1); PG8_STAGE(PG8_SA(1, 0), a3, voffA);
            PG8_BAR; PG8_WAIT_L(0); PG8_MMA(1, 0, At, B0); PG8_BAR; PG8_SCHED;
            PG8_STAGE(PG8_SB(1, 1), b3 + hstep, voffB);
            PG8_WAIT_V(6); PG8_BAR; PG8_MMA(1, 1, At, B1); PG8_BAR;
            }
        }
        if constexpr (ALIGN_EPI) { if (wr == 0) PG8_BAR; }
        if constexpr (!Epi::AFTER_DRAIN) { E(acc, cur, wr, wc, fr, fq); S.done(cur); }
        if (!has_next) break;
#pragma unroll
        for (int a = 0; a < 2; ++a)
#pragma unroll
            for (int b = 0; b < 2; ++b)
#pragma unroll
                for (int m = 0; m < 4; ++m)
#pragma unroll
                    for (int n = 0; n < 2; ++n) acc[a][b][m][n] = (f32x4){0.f, 0.f, 0.f, 0.f};
        cur = nxt; cA = nA; cB = nB; ++ui;
        if constexpr (ALIGN_EPI) { if (wr == 1) PG8_BAR; }
    }
    PG8_WAIT_V(0);
    if constexpr (!ALIGN_EPI) { if (wr == 0) PG8_BAR; }
    PG8_BAR;
    if constexpr (Epi::AFTER_DRAIN) { E.fused(acc, cur, wr, wc, fr, fq, lds, wid, lane); S.done(cur); }
#undef PG8_SA
#undef PG8_SB
#undef PG8_STAGE
#undef PG8_LDA
#undef PG8_LDB
#undef PG8_MMA
#undef PG8_WAIT_V
#undef PG8_WAIT_L
#undef PG8_BAR
#undef PG8_SCHED
}
}

#define LAS __attribute__((address_space(3)))
typedef unsigned short bf16_t;
typedef short bf16x8 __attribute__((ext_vector_type(8)));
typedef short s16x4 __attribute__((ext_vector_type(4)));
typedef float f32x4 __attribute__((ext_vector_type(4)));
typedef float f32x2 __attribute__((ext_vector_type(2)));
typedef float f32x16 __attribute__((ext_vector_type(16)));
typedef unsigned u32x4 __attribute__((ext_vector_type(4)));
typedef unsigned u32x2 __attribute__((ext_vector_type(2)));
typedef __bf16 bf16x2_t __attribute__((ext_vector_type(2)));

constexpr int NB = 8, SEQ = 4096, DM = 1024, DEPTH = 4, NMETA = 16;
constexpr int LV = SEQ + NMETA;
constexpr int LP = 4224;
constexpr int NR = NB * LP;
constexpr int DIN = 4168, NPAD = 4352;
constexpr int BW = 132;
constexpr float LN_EPS = 1e-5f;
constexpr float DN_ALPHA = 1.681792830507429f;
constexpr float QSCALE = 0.125f * 1.4426950408889634f;
constexpr float IDX_W_SCALE = 0.35355339059327373f;
constexpr int SSTR = 4232;
constexpr int LDS_BYTES = 157696;

constexpr size_t al256(size_t x) { return (x + 255) & ~(size_t)255; }
constexpr size_t WS_BAR = 0;
constexpr size_t WS_COS = 16384;
constexpr size_t WS_SIN = WS_COS + al256((size_t)LP * 32 * 4);
constexpr size_t WS_WIN = WS_SIN + al256((size_t)LP * 32 * 4);
constexpr size_t WS_WOUT = WS_WIN + (size_t)DEPTH * NPAD * 1024 * 2;
constexpr size_t WS_HB = WS_WOUT + (size_t)DEPTH * 1024 * 1024 * 2;
constexpr size_t SZ512 = (size_t)NR * 512 * 2;
constexpr size_t WS_U = WS_HB + (size_t)NR * 1024 * 2;
constexpr size_t WS_ZC = WS_U + SZ512;
constexpr size_t WS_Q = WS_ZC + SZ512;
constexpr size_t WS_K = WS_Q + SZ512;
constexpr size_t WS_V = WS_K + SZ512;
constexpr size_t WS_ZA = WS_V + SZ512;
constexpr size_t WS_QI = WS_ZA + SZ512;
constexpr size_t WS_KI = WS_QI + SZ512;
constexpr size_t WS_WI = WS_KI + (size_t)NR * 64 * 2;
constexpr size_t WS_YMIX = WS_WI + (size_t)NR * 8 * 4;
constexpr size_t WS_BITS = WS_YMIX + (size_t)NR * 1024 * 2;
constexpr size_t WS_METAH = WS_BITS + (size_t)NR * BW * 4;
constexpr size_t WS_STAT = WS_METAH + (size_t)NB * NMETA * 1024 * 4;
constexpr size_t WS_DUMP = WS_STAT + (size_t)NR * 2 * 4;
constexpr size_t WS_END = WS_DUMP + 4096;

struct Params {
    const float* x; const float* meta; const float* w_in; const float* conv_w; const float* conv_b;
    const float* conv_ln_g; const float* conv_ln_b; const float* w_out; const float* post_g; const float* post_b;
    float* out; unsigned char* ws;
};

__device__ __forceinline__ unsigned pk2(float lo, float hi) { f32x2 v = {lo, hi}; bf16x2_t b = __builtin_convertvector(v, bf16x2_t); return __builtin_bit_cast(unsigned, b); }
__device__ __forceinline__ float bflo(unsigned w) { return __uint_as_float(w << 16); }
__device__ __forceinline__ float bfhi(unsigned w) { return __uint_as_float(w & 0xffff0000u); }
__device__ __forceinline__ float sigmoidf_(float x) { return __builtin_amdgcn_rcpf(1.0f + __expf(-x)); }
__device__ __forceinline__ float wave_sum(float v) {
#pragma unroll
    for (int o = 1; o < 64; o <<= 1) v += __shfl_xor(v, o);
    return v;
}

__device__ __forceinline__ int in_colmap(int c) {
    const int pn = c >> 8, w = c & 255;
    if (pn < 4) return (w < 128) ? (128 * pn + w) : (512 + 128 * pn + (w - 128));
    if (pn == 16) { if (w < 64) return 4096 + (w >> 1) + 32 * (w & 1); if (w < 72) return 4160 + (w - 64); return -1; }
    const int kind = (pn - 4) >> 1;
    const int base = 1024 + 512 * kind + 256 * (pn & 1);
    if (kind == 1 || kind == 2 || kind == 5) return base + 64 * (w >> 6) + ((w & 63) >> 1) + 32 * (w & 1);
    return base + w;
}

struct EpiIn {
    static constexpr bool PERM = true, AFTER_DRAIN = false;
    bf16_t *U, *ZC, *Q, *K, *V, *ZA, *QI, *KI; float* WI; const float* cosT; const float* sinT;
    __device__ __forceinline__ void operator()(const pg8::f32x4 (&acc)[2][2][4][2], const pg8::Unit& u, int wr, int wc, int fr, int fq) const {
        const int pn = u.pn;
        const int row0 = u.pm * 256 + wr * 64 + fr;
        const int w0 = wc * 32 + 8 * fq;
        if (pn < 4) {
#pragma unroll
            for (int ai = 0; ai < 2; ++ai)
#pragma unroll
                for (int m = 0; m < 4; ++m) {
                    const int r = row0 + ai * 128 + m * 16;
                    const pg8::f32x4 a0 = acc[ai][0][m][0], a1 = acc[ai][0][m][1], g0 = acc[ai][1][m][0], g1 = acc[ai][1][m][1];
                    u32x4 w;
                    w.x = pk2(a0[0] * sigmoidf_(g0[0]), a0[1] * sigmoidf_(g0[1])); w.y = pk2(a0[2] * sigmoidf_(g0[2]), a0[3] * sigmoidf_(g0[3]));
                    w.z = pk2(a1[0] * sigmoidf_(g1[0]), a1[1] * sigmoidf_(g1[1])); w.w = pk2(a1[2] * sigmoidf_(g1[2]), a1[3] * sigmoidf_(g1[3]));
                    *(u32x4*)(U + (size_t)r * 512 + pn * 128 + w0) = w;
                }
        } else if (pn == 16) {
            if (w0 < 64) {
                const int i0 = w0 >> 1;
#pragma unroll
                for (int ai = 0; ai < 2; ++ai)
#pragma unroll
                    for (int m = 0; m < 4; ++m) {
                        const int r = row0 + ai * 128 + m * 16; const int t = r % LP;
                        const f32x4 c4 = *(const f32x4*)(cosT + t * 32 + i0), s4 = *(const f32x4*)(sinT + t * 32 + i0);
                        const pg8::f32x4 v0 = acc[ai][0][m][0], v1 = acc[ai][0][m][1];
                        u32x4 w;
                        w.x = pk2(v0[0] * c4[0] - v0[1] * s4[0], v0[1] * c4[0] + v0[0] * s4[0]);
                        w.y = pk2(v0[2] * c4[1] - v0[3] * s4[1], v0[3] * c4[1] + v0[2] * s4[1]);
                        w.z = pk2(v1[0] * c4[2] - v1[1] * s4[2], v1[1] * c4[2] + v1[0] * s4[2]);
                        w.w = pk2(v1[2] * c4[3] - v1[3] * s4[3], v1[3] * c4[3] + v1[2] * s4[3]);
                        *(u32x4*)(KI + (size_t)r * 64 + w0) = w;
                    }
            } else if (w0 == 64) {
#pragma unroll
                for (int ai = 0; ai < 2; ++ai)
#pragma unroll
                    for (int m = 0; m < 4; ++m) {
                        const int r = row0 + ai * 128 + m * 16;
                        *(f32x4*)(WI + (size_t)r * 8) = acc[ai][0][m][0] * IDX_W_SCALE;
                        *(f32x4*)(WI + (size_t)r * 8 + 4) = acc[ai][0][m][1] * IDX_W_SCALE;
                    }
            }
        } else {
            const int kind = (pn - 4) >> 1;
            bf16_t* base = kind == 0 ? ZC : kind == 1 ? Q : kind == 2 ? K : kind == 3 ? V : kind == 4 ? ZA : QI;
            const int cb = (pn & 1) * 256 + w0;
            if (kind == 0 || kind == 4) {
#pragma unroll
                for (int ai = 0; ai < 2; ++ai)
#pragma unroll
                    for (int m = 0; m < 4; ++m) {
                        const int r = row0 + ai * 128 + m * 16;
#pragma unroll
                        for (int bj = 0; bj < 2; ++bj) {
                            const pg8::f32x4 v0 = acc[ai][bj][m][0], v1 = acc[ai][bj][m][1];
                            u32x4 w;
                            w.x = pk2(v0[0] * sigmoidf_(v0[0]), v0[1] * sigmoidf_(v0[1])); w.y = pk2(v0[2] * sigmoidf_(v0[2]), v0[3] * sigmoidf_(v0[3]));
                            w.z = pk2(v1[0] * sigmoidf_(v1[0]), v1[1] * sigmoidf_(v1[1])); w.w = pk2(v1[2] * sigmoidf_(v1[2]), v1[3] * sigmoidf_(v1[3]));
                            *(u32x4*)(base + (size_t)r * 512 + cb + bj * 128) = w;
                        }
                    }
            } else if (kind == 3) {
#pragma unroll
                for (int ai = 0; ai < 2; ++ai)
#pragma unroll
                    for (int m = 0; m < 4; ++m) {
                        const int r = row0 + ai * 128 + m * 16;
#pragma unroll
                        for (int bj = 0; bj < 2; ++bj) {
                            const pg8::f32x4 v0 = acc[ai][bj][m][0], v1 = acc[ai][bj][m][1];
                            u32x4 w; w.x = pk2(v0[0], v0[1]); w.y = pk2(v0[2], v0[3]); w.z = pk2(v1[0], v1[1]); w.w = pk2(v1[2], v1[3]);
                            *(u32x4*)(base + (size_t)r * 512 + cb + bj * 128) = w;
                        }
                    }
            } else {
                const float sc = kind == 1 ? QSCALE : kind == 5 ? 0.125f : 1.0f;
                const int i0 = (w0 & 63) >> 1;
                f32x4 cN = *(const f32x4*)(cosT + (row0 % LP) * 32 + i0), sN = *(const f32x4*)(sinT + (row0 % LP) * 32 + i0);
#pragma unroll
                for (int g8 = 0; g8 < 8; ++g8) {
                    const int ai = g8 >> 2, m = g8 & 3;
                    const int r = row0 + ai * 128 + m * 16;
                    const f32x4 c4 = cN * sc, s4 = sN * sc;
                    if (g8 < 7) { const int rn = row0 + ((g8 + 1) >> 2) * 128 + ((g8 + 1) & 3) * 16; const int tn = rn % LP; cN = *(const f32x4*)(cosT + tn * 32 + i0); sN = *(const f32x4*)(sinT + tn * 32 + i0); }
#pragma unroll
                    for (int bj = 0; bj < 2; ++bj) {
                        const pg8::f32x4 v0 = acc[ai][bj][m][0], v1 = acc[ai][bj][m][1];
                        u32x4 w;
                        w.x = pk2(v0[0] * c4[0] - v0[1] * s4[0], v0[1] * c4[0] + v0[0] * s4[0]);
                        w.y = pk2(v0[2] * c4[1] - v0[3] * s4[1], v0[3] * c4[1] + v0[2] * s4[1]);
                        w.z = pk2(v1[0] * c4[2] - v1[1] * s4[2], v1[1] * c4[2] + v1[0] * s4[2]);
                        w.w = pk2(v1[2] * c4[3] - v1[3] * s4[3], v1[3] * c4[3] + v1[2] * s4[3]);
                        *(u32x4*)(base + (size_t)r * 512 + cb + bj * 128) = w;
                    }
                }
            }
        }
    }
};

struct EpiOut {
    static constexpr bool PERM = false, AFTER_DRAIN = false;
    const float* src_main; const float* src_meta; int src_meta_bstride; float* dst_main; float* dst_meta;
    const float* stat; const float* pg; const float* pb;
    float* dump;
    __device__ __forceinline__ void rowp(int r, const float*& sp, float*& dp) const {
        const int b = r / LP, t = r - b * LP;
        if (t < NMETA) { sp = src_meta + (size_t)b * src_meta_bstride + t * 1024; dp = dst_meta + (size_t)(b * NMETA + t) * 1024; }
        else { const int tt = t < LV ? t : NMETA; const size_t o = ((size_t)b * SEQ + (tt - NMETA)) * 1024; sp = src_main + o; dp = (t < LV) ? (dst_main + o) : dump; }
    }
    __device__ __forceinline__ void operator()(const pg8::f32x4 (&acc)[2][2][4][2], const pg8::Unit& u, int wr, int wc, int fr, int fq) const {
        const int col0 = u.pn * 256 + wc * 32 + 4 * fq;
        const int row0 = u.pm * 256 + wr * 64 + fr;
        const bool rebuild = stat != nullptr;
        f32x4 g4[2][2], b4[2][2];
#pragma unroll
        for (int bj = 0; bj < 2; ++bj)
#pragma unroll
            for (int n = 0; n < 2; ++n) { g4[bj][n] = (f32x4){1.f, 1.f, 1.f, 1.f}; b4[bj][n] = (f32x4){0.f, 0.f, 0.f, 0.f};
                if (rebuild) { g4[bj][n] = *(const f32x4*)(pg + col0 + bj * 128 + n * 16); b4[bj][n] = *(const f32x4*)(pb + col0 + bj * 128 + n * 16); } }
        const float* spn; float* dpn; rowp(row0, spn, dpn);
        f32x4 hvn[2][2]; f32x2 stn = {0.f, 1.f};
#pragma unroll
        for (int bj = 0; bj < 2; ++bj)
#pragma unroll
            for (int n = 0; n < 2; ++n) hvn[bj][n] = *(const f32x4*)(spn + col0 + bj * 128 + n * 16);
        if (rebuild) stn = *(const f32x2*)(stat + (size_t)row0 * 2);
#pragma unroll
        for (int g8 = 0; g8 < 8; ++g8) {
            const int ai = g8 >> 2, m = g8 & 3;
            f32x4 hv[2][2]; const f32x2 st = stn; float* dp = dpn;
#pragma unroll
            for (int bj = 0; bj < 2; ++bj)
#pragma unroll
                for (int n = 0; n < 2; ++n) hv[bj][n] = hvn[bj][n];
            if (g8 < 7) {
                const int rn = row0 + ((g8 + 1) >> 2) * 128 + ((g8 + 1) & 3) * 16; rowp(rn, spn, dpn);
#pragma unroll
                for (int bj = 0; bj < 2; ++bj)
#pragma unroll
                    for (int n = 0; n < 2; ++n) hvn[bj][n] = *(const f32x4*)(spn + col0 + bj * 128 + n * 16);
                if (rebuild) stn = *(const f32x2*)(stat + (size_t)rn * 2);
            }
#pragma unroll
            for (int bj = 0; bj < 2; ++bj)
#pragma unroll
                for (int n = 0; n < 2; ++n) {
                    f32x4 h = hv[bj][n];
                    if (rebuild) h = (h - st[0]) * st[1] * g4[bj][n] + b4[bj][n];
                    *(f32x4*)(dp + col0 + bj * 128 + n * 16) = h * DN_ALPHA + acc[ai][bj][m][n];
                }
        }
    }
};

template <bool MAPPED>
__device__ __forceinline__ void p0_transpose_item(const float* W, int N, bf16_t* WT, LAS float* scr, int kb, int nb, int lane) {
    const int k0 = 64 * kb, n0 = 32 * nb;
    const int col = MAPPED ? in_colmap(n0 + (lane & 31)) : (n0 + (lane & 31));
    float wreg[32];
#pragma unroll
    for (int i = 0; i < 32; ++i) { const int kk = 2 * i + (lane >> 5); wreg[i] = (col >= 0) ? W[(size_t)(k0 + kk) * N + col] : 0.f; }
#pragma unroll
    for (int i = 0; i < 32; ++i) { const int kk = 2 * i + (lane >> 5); scr[kk * 33 + (lane & 31)] = wreg[i]; }
    asm volatile("s_waitcnt lgkmcnt(0)" ::: "memory");
    const int c = lane & 7;
#pragma unroll
    for (int j = 0; j < 4; ++j) { const int n = (lane >> 3) + 8 * j; const LAS float* s = scr + (8 * c) * 33 + n;
        u32x4 o; o.x = pk2(s[0 * 33], s[1 * 33]); o.y = pk2(s[2 * 33], s[3 * 33]); o.z = pk2(s[4 * 33], s[5 * 33]); o.w = pk2(s[6 * 33], s[7 * 33]);
        *(u32x4*)(WT + (size_t)(n0 + n) * 1024 + k0 + 8 * c) = o; }
    asm volatile("s_waitcnt lgkmcnt(0)" ::: "memory");
}

__device__ __forceinline__ void p0_prologue(const Params& p, LAS unsigned char* lds, int wave, int lane) {
    unsigned char* ws = p.ws;
    LAS float* scr = (LAS float*)(lds + wave * 8704);
    const int gw = blockIdx.x * 8 + wave, NGW = gridDim.x * 8;
    constexpr int IT_IN = 16 * (NPAD / 32), IT_OUT = 16 * 32, IT_L = IT_IN + IT_OUT;
    for (int it = gw; it < DEPTH * IT_L; it += NGW) {
        const int l = it / IT_L; int r = it - l * IT_L;
        if (r < IT_IN) { const int kb = r / (NPAD / 32), nb = r - kb * (NPAD / 32);
            p0_transpose_item<true>(p.w_in + (size_t)l * 1024 * DIN, DIN, (bf16_t*)(ws + WS_WIN) + (size_t)l * NPAD * 1024, scr, kb, nb, lane); }
        else { r -= IT_IN; const int kb = r / 32, nb = r - kb * 32;
            p0_transpose_item<false>(p.w_out + (size_t)l * 1024 * 1024, 1024, (bf16_t*)(ws + WS_WOUT) + (size_t)l * 1024 * 1024, scr, kb, nb, lane); }
    }
    bf16_t* HB = (bf16_t*)(ws + WS_HB);
    for (int r0 = gw; r0 < NR; r0 += 4 * NGW) {
        f32x4 va[4][4]; bool live[4]; int rr[4];
#pragma unroll
        for (int k = 0; k < 4; ++k) {
            const int r = r0 + k * NGW; rr[k] = r; live[k] = false;
            const int rc = r < NR ? r : r0; const int b = rc / LP, t = rc - b * LP;
            const float* src = (t < NMETA) ? (p.meta + (size_t)t * 1024) : (p.x + ((size_t)b * SEQ + ((t < LV ? t : NMETA) - NMETA)) * 1024);
            live[k] = (r < NR) && (t < LV);
#pragma unroll
            for (int j = 0; j < 4; ++j) va[k][j] = *((const f32x4*)src + lane + 64 * j);
        }
#pragma unroll
        for (int k = 0; k < 4; ++k) {
            if (rr[k] < NR) {
                u32x2* o = (u32x2*)(HB + (size_t)rr[k] * 1024) + lane;
#pragma unroll
                for (int j = 0; j < 4; ++j) { u32x2 w; w.x = live[k] ? pk2(va[k][j][0], va[k][j][1]) : 0u; w.y = live[k] ? pk2(va[k][j][2], va[k][j][3]) : 0u; o[64 * j] = w; }
            }
        }
    }
    float* cosT = (float*)(ws + WS_COS); float* sinT = (float*)(ws + WS_SIN);
    for (int i = blockIdx.x * 512 + threadIdx.x; i < LP * 32; i += gridDim.x * 512) {
        const int t = i >> 5, f = i & 31;
        const float inv_freq = powf(10000.0f, -(float)(2 * f) / 64.0f);
        const float ang = (float)t * inv_freq;
        const double rev = (double)ang * 0.15915494309189535;
        const float fr = (float)(rev - floor(rev));
        cosT[i] = __builtin_amdgcn_cosf(fr); sinT[i] = __builtin_amdgcn_sinf(fr);
    }
}

#ifndef REP_SCORE
#define REP_SCORE 1
#endif
#ifndef REP_SEL
#define REP_SEL 1
#endif
constexpr int P2_HIST = 8 * SSTR * 4, P2_RS = P2_HIST + 8 * 512 * 4, P2_CAND = P2_RS + 64, P2_CIDX = P2_CAND + 8 * 64 * 4, P2_END = P2_CIDX + 8 * 64 * 4;
static_assert(P2_END <= LDS_BYTES, "P2 LDS map");
__device__ __forceinline__ int score_bin(float sc, float rs) { const float f = __builtin_amdgcn_fmed3f(__builtin_fmaf(sc, rs, 256.0f), 0.f, 511.f); return (int)f; }
__device__ __forceinline__ unsigned ord_key(float f) { const unsigned u = __float_as_uint(f); return (u & 0x80000000u) ? ~u : (u | 0x80000000u); }

__device__ __forceinline__ void select_bisect(const LAS float* Sr, unsigned long long* brow, int nj, int lane) {
    unsigned key[66];
#pragma unroll
    for (int j = 0; j < 66; ++j) { key[j] = 0u; if (j < nj) key[j] = ord_key(Sr[64 * j + lane]); }
    unsigned prefix = 0u; bool exact = false;
    for (int bit = 31; bit >= 0; --bit) {
        const unsigned cand = prefix | (1u << bit);
        int cnt = 0;
#pragma unroll
        for (int gq = 0; gq < 5; ++gq) if (gq * 16 < nj) {
#pragma unroll
            for (int jj = 0; jj < 16; ++jj) { const int j = gq * 16 + jj; if (j < 66) cnt += __popcll(__ballot(key[j] >= cand)); }
        }
        if (cnt >= 256) { prefix = cand; if (cnt == 256) { exact = true; break; } }
    }
    const unsigned thr = prefix;
    int need = 1 << 30;
    if (!exact) { int cgt = 0;
#pragma unroll
        for (int j = 0; j < 66; ++j) if (j < nj) cgt += __popcll(__ballot(key[j] > thr));
        need = 256 - cgt; }
    int eqb = 0;
#pragma unroll
    for (int j = 0; j < 66; ++j) if (j < nj) {
        const bool gt = key[j] > thr, eq = key[j] == thr;
        const unsigned long long em = __ballot(eq);
        const int rank = eqb + (int)__builtin_amdgcn_mbcnt_hi((unsigned)(em >> 32), __builtin_amdgcn_mbcnt_lo((unsigned)em, 0u));
        const bool sel = gt || (eq && rank < need);
        const unsigned long long sm = __ballot(sel);
        if (lane == 0) brow[j] = sm;
        eqb += __popcll(em);
    }
}

__device__ __forceinline__ void idx_item(int b, int g, const bf16_t* QI, const bf16_t* KI, const float* WI, unsigned* BITS, LAS unsigned char* lds, int tid, int wave, int lane) {
    LAS float* S = (LAS float*)lds; LAS unsigned* HIST = (LAS unsigned*)(lds + P2_HIST); LAS float* RS = (LAS float*)(lds + P2_RS);
    LAS unsigned* CAND = (LAS unsigned*)(lds + P2_CAND); LAS unsigned* CIDX = (LAS unsigned*)(lds + P2_CIDX);
    const int t0 = 8 * g; const int nj = t0 / 64 + 1; const int NT32 = 2 * nj;
    const int m = lane & 31, hh = lane >> 5;
#pragma unroll
    for (int i = 0; i < 8; ++i) HIST[tid + 512 * i] = 0u;
    if (tid < 8) { const float* wp = WI + (size_t)(b * LP + t0 + tid) * 8; const f32x4 lo = *(const f32x4*)wp, hi = *(const f32x4*)(wp + 4);
        const float ss = (lo[0] * lo[0] + lo[1] * lo[1]) + (lo[2] * lo[2] + lo[3] * lo[3]) + (hi[0] * hi[0] + hi[1] * hi[1]) + (hi[2] * hi[2] + hi[3] * hi[3]);
        RS[tid] = 32.0f / sqrtf(0.5f * ss + 1e-20f); }
    {
        const int aq = 2 * ((m >> 2) & 1) + (m >> 4), ah = 4 * ((m >> 3) & 1) + (m & 3);
        bf16x8 af[2][4];
#pragma unroll
        for (int mb = 0; mb < 2; ++mb)
#pragma unroll
            for (int ks = 0; ks < 4; ++ks) af[mb][ks] = *(const bf16x8*)(QI + (size_t)(b * LP + t0 + 4 * mb + aq) * 512 + ah * 64 + ks * 16 + hh * 8);
        float wv[2][2][8];
#pragma unroll
        for (int mb = 0; mb < 2; ++mb)
#pragma unroll
            for (int qq = 0; qq < 2; ++qq) { const size_t row = (size_t)(b * LP + t0 + 4 * mb + 2 * hh + qq);
                const f32x4 lo = *(const f32x4*)(WI + row * 8), hi = *(const f32x4*)(WI + row * 8 + 4);
                wv[mb][qq][0] = lo[0]; wv[mb][qq][1] = lo[1]; wv[mb][qq][2] = lo[2]; wv[mb][qq][3] = lo[3];
                wv[mb][qq][4] = hi[0]; wv[mb][qq][5] = hi[1]; wv[mb][qq][6] = hi[2]; wv[mb][qq][7] = hi[3]; }
        const bf16_t* kbase = KI + (size_t)(b * LP + m) * 64 + hh * 8;
#define IDX_LOADB(dst, tile) do { _Pragma("unroll") for (int ks = 0; ks < 4; ++ks) dst[ks] = *(const bf16x8*)(kbase + (size_t)(32 * (tile)) * 64 + ks * 16); } while (0)
        bf16x8 kb0[4], kb1[4], kb2[4];
        for (int rsc_ = 0; rsc_ < REP_SCORE; ++rsc_) {
        const bool dh = (rsc_ == REP_SCORE - 1);
        int tl = wave;
        if (tl < NT32) IDX_LOADB(kb0, tl);
        if (tl + 8 < NT32) IDX_LOADB(kb1, tl + 8);
        if (tl + 16 < NT32) IDX_LOADB(kb2, tl + 16);
        __syncthreads();
        float rsv[2][2];
#pragma unroll
        for (int mb = 0; mb < 2; ++mb)
#pragma unroll
            for (int qq = 0; qq < 2; ++qq) rsv[mb][qq] = RS[4 * mb + 2 * hh + qq];
#define IDX_TILE(kb, tile) do { \
            const int s = 32 * (tile) + m; \
            f32x16 c0 = {}, c1 = {}; \
            _Pragma("unroll") for (int ks = 0; ks < 4; ++ks) { c0 = __builtin_amdgcn_mfma_f32_32x32x16_bf16(af[0][ks], kb[ks], c0, 0, 0, 0); c1 = __builtin_amdgcn_mfma_f32_32x32x16_bf16(af[1][ks], kb[ks], c1, 0, 0, 0); } \
            if ((tile) + 24 < NT32) IDX_LOADB(kb, (tile) + 24); \
            _Pragma("unroll") for (int qq = 0; qq < 2; ++qq) { \
                float s0 = 0.f, s1 = 0.f;     \
                _Pragma("unroll") for (int h = 0; h < 8; ++h) { s0 = fmaf(wv[0][qq][h], __builtin_amdgcn_fmed3f(c0[8 * qq + h], 0.f, 3.0e38f), s0); s1 = fmaf(wv[1][qq][h], __builtin_amdgcn_fmed3f(c1[8 * qq + h], 0.f, 3.0e38f), s1); } \
                const int q0 = 2 * hh + qq, q1 = 4 + 2 * hh + qq; \
                if (s <= t0 + q0) { if (dh) __hip_atomic_fetch_add(HIST + q0 * 512 + score_bin(s0, rsv[0][qq]), 1u, __ATOMIC_RELAXED, __HIP_MEMORY_SCOPE_WORKGROUP); } else s0 = -INFINITY; \
                if (s <= t0 + q1) { if (dh) __hip_atomic_fetch_add(HIST + q1 * 512 + score_bin(s1, rsv[1][qq]), 1u, __ATOMIC_RELAXED, __HIP_MEMORY_SCOPE_WORKGROUP); } else s1 = -INFINITY; \
                S[q0 * SSTR + s] = s0; S[q1 * SSTR + s] = s1; \
            } } while (0)
        for (; tl < NT32; tl += 24) {
            IDX_TILE(kb0, tl);
            if (tl + 8 < NT32) IDX_TILE(kb1, tl + 8);
            if (tl + 16 < NT32) IDX_TILE(kb2, tl + 16);
        }
        }
#undef IDX_TILE
#undef IDX_LOADB
    }
    __syncthreads();
    for (int rse_ = 0; rse_ < REP_SEL; ++rse_) {
        const int t = t0 + wave;
        const LAS float* Sr = S + wave * SSTR;
        unsigned long long* brow = (unsigned long long*)(BITS + (size_t)(b * LP + t) * BW);
        if (t < 256) {
            for (int j = 0; j < nj; ++j) { const unsigned long long mk = __ballot((64 * j + lane) <= t); if (lane == 0) brow[j] = mk; }
        } else {
            const LAS unsigned* H = HIST + wave * 512;
            const u32x4 ha = *(const LAS u32x4*)(H + 8 * lane), hb = *(const LAS u32x4*)(H + 8 * lane + 4);
            const unsigned lsum = (ha.x + ha.y) + (ha.z + ha.w) + (hb.x + hb.y) + (hb.z + hb.w);
            unsigned incl = lsum;
#pragma unroll
            for (int o = 1; o < 64; o <<= 1) { const unsigned v = __shfl_down(incl, o); if (lane + o < 64) incl += v; }
            unsigned cum = incl - lsum; int Bsel = -1; unsigned cab = 0u;
#define P2_STEP(hv, i) do { if (Bsel < 0 && cum < 256u && cum + (hv) >= 256u) { Bsel = 8 * lane + (i); cab = cum; } cum += (hv); } while (0)
            P2_STEP(hb.w, 7); P2_STEP(hb.z, 6); P2_STEP(hb.y, 5); P2_STEP(hb.x, 4); P2_STEP(ha.w, 3); P2_STEP(ha.z, 2); P2_STEP(ha.y, 1); P2_STEP(ha.x, 0);
#undef P2_STEP
            const unsigned long long fm = __ballot(Bsel >= 0);
            const int src = (int)__ffsll((unsigned long long)fm) - 1;
            const int Bb = __builtin_amdgcn_readlane(Bsel, src);
            const int c_above = __builtin_amdgcn_readlane((int)cab, src);
            const int cB = (int)H[Bb];
            const int rr = 256 - c_above;
            if (fm == 0ull || cB > 64 || rr < 1 || rr > cB) {
                select_bisect(Sr, brow, nj, lane);
            } else {
                const float rs = RS[wave];
                const float hiT = (Bb >= 511) ? INFINITY : (float)(Bb + 1), loT = (Bb <= 0) ? -INFINITY : (float)Bb;
                const int jt = t >> 6; const unsigned long long tailm = (~0ull) >> (63 - (t & 63));
                unsigned long long w0 = 0ull, w1 = 0ull;
                int cnt = 0;
#define SEL_CHUNK(fv, j, vm) do { \
                        const float vv = __builtin_fmaf((fv), rs, 256.0f); \
                        const unsigned long long mh = __ballot(vv >= hiT) & (vm); \
                        const unsigned long long mc = __ballot(vv >= loT) & (vm) & ~mh; \
                        if (lane == ((j) & 63)) { if ((j) < 64) w0 = mh; else w1 = mh; } \
                        if (mc != 0ull) { \
                            const bool is = (mc >> lane) & 1ull; \
                            const int pos = cnt + (int)__builtin_amdgcn_mbcnt_hi((unsigned)(mc >> 32), __builtin_amdgcn_mbcnt_lo((unsigned)mc, 0u)); \
                            if (is && pos < 64) { CAND[wave * 64 + pos] = ord_key(fv); CIDX[wave * 64 + pos] = (unsigned)(64 * (j) + lane); } \
                            cnt += __popcll(mc); \
                        } } while (0)
                int j0 = 0;
                for (; j0 + 4 <= jt; j0 += 4) {
                    float f4[4];
#pragma unroll
                    for (int i = 0; i < 4; ++i) f4[i] = Sr[64 * (j0 + i) + lane];
#pragma unroll
                    for (int i = 0; i < 4; ++i) SEL_CHUNK(f4[i], j0 + i, ~0ull);
                }
                for (; j0 <= jt; ++j0) {
                    const float f1 = Sr[64 * j0 + lane];
                    const unsigned long long vm = (j0 < jt) ? ~0ull : tailm;
                    SEL_CHUNK(f1, j0, vm);
                }
#undef SEL_CHUNK
                asm volatile("s_waitcnt lgkmcnt(0)" ::: "memory");
                const unsigned myk = (lane < cB) ? CAND[wave * 64 + lane] : 0u;
                const unsigned myi = (lane < cB) ? CIDX[wave * 64 + lane] : 0u;
                int rank = 0;
                for (int jj = 0; jj < cB; ++jj) { const unsigned kj = (unsigned)__builtin_amdgcn_readlane((int)myk, jj); rank += ((kj > myk) || (kj == myk && jj < lane)) ? 1 : 0; }
                unsigned long long chosen = __ballot(lane < cB && rank < rr);
                while (chosen != 0ull) {
                    const int c = (int)__ffsll((unsigned long long)chosen) - 1; chosen &= chosen - 1ull;
                    const unsigned ci = (unsigned)__builtin_amdgcn_readlane((int)myi, c);
                    const int jc = (int)(ci >> 6); const unsigned long long bit = 1ull << (ci & 63u);
                    if (lane == (jc & 63)) { if (jc < 64) w0 |= bit; else w1 |= bit; }
                }
                if (lane < nj) brow[lane] = w0;
                if (lane < 2 && 64 + lane < nj) brow[64 + lane] = w1;
            }
        }
    }
    __syncthreads();
}

__device__ __forceinline__ void conv_tile(int b, int ti, const bf16_t* U, const bf16_t* ZC, const float* cw, const float* cb, const float* lg, const float* lb,
                                          bf16_t* YMIX, LAS float* C, int tid, int wave, int lane) {
    const int t0 = 32 * ti;
    {
        const int cp = tid & 255, rh = tid >> 8;
        float w0[31], w1[31];
#pragma unroll
        for (int j = 0; j < 31; ++j) { const f32x2 ww = *(const f32x2*)(cw + j * 512 + 2 * cp); w0[j] = ww[0]; w1[j] = ww[1]; }
        const f32x2 bias = *(const f32x2*)(cb + 2 * cp);
        float x0[46], x1[46];
#pragma unroll
        for (int i = 0; i < 46; ++i) { const int t = t0 - 30 + 16 * rh + i; x0[i] = 0.f; x1[i] = 0.f;
            if (t >= 0) { const unsigned pu = *(const unsigned*)(U + (size_t)(b * LP + t) * 512 + 2 * cp); x0[i] = bflo(pu); x1[i] = bfhi(pu); } }
#pragma unroll
        for (int o = 0; o < 16; ++o) { float a0 = bias[0], a1 = bias[1];
#pragma unroll
            for (int j = 0; j < 31; ++j) { a0 = fmaf(w0[j], x0[o + j], a0); a1 = fmaf(w1[j], x1[o + j], a1); }
            f32x2 r2; r2[0] = a0; r2[1] = a1; *(LAS f32x2*)(C + (16 * rh + o) * 512 + 2 * cp) = r2; }
    }
    const f32x4 g0 = *(const f32x4*)(lg + lane * 8), g1 = *(const f32x4*)(lg + lane * 8 + 4), b0 = *(const f32x4*)(lb + lane * 8), b1 = *(const f32x4*)(lb + lane * 8 + 4);
    u32x4 zz[4];
#pragma unroll
    for (int rr = 0; rr < 4; ++rr) zz[rr] = *(const u32x4*)(ZC + (size_t)(b * LP + t0 + 4 * wave + rr) * 512 + lane * 8);
    asm volatile("s_waitcnt lgkmcnt(0)\n\ts_barrier" ::: "memory");
    {
        f32x4 a0[4], a1[4]; float sm[4], sq[4];
#pragma unroll
        for (int rr = 0; rr < 4; ++rr) { const LAS float* cr = C + (4 * wave + rr) * 512 + lane * 8; a0[rr] = *(const LAS f32x4*)cr; a1[rr] = *(const LAS f32x4*)(cr + 4);
            sm[rr] = (a0[rr][0] + a0[rr][1]) + (a0[rr][2] + a0[rr][3]) + (a1[rr][0] + a1[rr][1]) + (a1[rr][2] + a1[rr][3]); }
#pragma unroll
        for (int o = 1; o < 64; o <<= 1) {
#pragma unroll
            for (int rr = 0; rr < 4; ++rr) sm[rr] += __shfl_xor(sm[rr], o); }
#pragma unroll
        for (int rr = 0; rr < 4; ++rr) { const float mean = sm[rr] * (1.f / 512.f); a0[rr] = a0[rr] - mean; a1[rr] = a1[rr] - mean;
            sq[rr] = (a0[rr][0] * a0[rr][0] + a0[rr][1] * a0[rr][1]) + (a0[rr][2] * a0[rr][2] + a0[rr][3] * a0[rr][3]) + (a1[rr][0] * a1[rr][0] + a1[rr][1] * a1[rr][1]) + (a1[rr][2] * a1[rr][2] + a1[rr][3] * a1[rr][3]); }
#pragma unroll
        for (int o = 1; o < 64; o <<= 1) {
#pragma unroll
            for (int rr = 0; rr < 4; ++rr) sq[rr] += __shfl_xor(sq[rr], o); }
#pragma unroll
        for (int rr = 0; rr < 4; ++rr) {
            const float rstd = 1.0f / sqrtf(sq[rr] * (1.f / 512.f) + LN_EPS);
            const size_t row = (size_t)(b * LP + t0 + 4 * wave + rr);
            const u32x4 z = zz[rr];
            const f32x4 y0 = a0[rr] * rstd * g0 + b0, y1 = a1[rr] * rstd * g1 + b1;
            u32x4 w;
            w.x = pk2(y0[0] * sigmoidf_(y0[0]) * bflo(z.x), y0[1] * sigmoidf_(y0[1]) * bfhi(z.x));
            w.y = pk2(y0[2] * sigmoidf_(y0[2]) * bflo(z.y), y0[3] * sigmoidf_(y0[3]) * bfhi(z.y));
            w.z = pk2(y1[0] * sigmoidf_(y1[0]) * bflo(z.z), y1[1] * sigmoidf_(y1[1]) * bfhi(z.z));
            w.w = pk2(y1[2] * sigmoidf_(y1[2]) * bflo(z.w), y1[3] * sigmoidf_(y1[3]) * bfhi(z.w));
            *(u32x4*)(YMIX + row * 1024 + lane * 8) = w;
        }
    }
    asm volatile("s_waitcnt lgkmcnt(0)\n\ts_barrier" ::: "memory");
}

constexpr int KSTR = 272, VSTR = 320;
typedef short v4i16_t __attribute__((ext_vector_type(4)));
__device__ __forceinline__ float vmax3(float a, float b, float c) { float r; asm("v_max3_f32 %0, %1, %2, %3" : "=v"(r) : "v"(a), "v"(b), "v"(c)); return r; }
#define bfe1(w, c) ({ unsigned m_; asm("v_bfe_i32 %0, %1, %2, 1" : "=v"(m_) : "v"(w), "n"(c)); m_; })
__device__ __forceinline__ void attn_unit(int b, int hp, int qb, const bf16_t* Q, const bf16_t* K, const bf16_t* V, const bf16_t* ZA, const unsigned* BITS, bf16_t* YMIX,
                                          LAS unsigned char* lds, int tid, int wave, int lane) {
    const int hl = wave >> 2, h = 2 * hp + hl;
    const int q0 = 128 * qb, qw0 = q0 + 32 * (wave & 3);
    const int n = lane & 31, hh = lane >> 5;
    const size_t qrow = (size_t)(b * LP + qw0 + n);
    bf16x8 qf[4];
#pragma unroll
    for (int ks = 0; ks < 4; ++ks) qf[ks] = *(const bf16x8*)(Q + qrow * 512 + h * 64 + ks * 16 + hh * 8);
    const int NT = 2 * qb + 2;
    LAS unsigned char* Ks = lds; LAS unsigned char* Vs = lds + 2 * 64 * KSTR;
    const int r0 = tid >> 4, ch = tid & 15;
    const size_t gb = (size_t)(b * LP) * 512 + hp * 128 + ch * 8;
    u32x4 kA0, kA1, vA0, vA1, kB0, kB1, vB0, vB1;
#define ATT_LOAD(tile, k0, k1, v0, v1) do { const size_t ro = gb + (size_t)(64 * (tile) + r0) * 512; k0 = *(const u32x4*)(K + ro); k1 = *(const u32x4*)(K + ro + 32 * 512); v0 = *(const u32x4*)(V + ro); v1 = *(const u32x4*)(V + ro + 32 * 512); } while (0)
#define ATT_STORE(buf, k0, k1, v0, v1) do { *(LAS u32x4*)(Ks + (buf) * 64 * KSTR + r0 * KSTR + ch * 16) = k0; *(LAS u32x4*)(Ks + (buf) * 64 * KSTR + (r0 + 32) * KSTR + ch * 16) = k1; \
        *(LAS u32x4*)(Vs + (buf) * 64 * VSTR + r0 * VSTR + ch * 16) = v0; *(LAS u32x4*)(Vs + (buf) * 64 * VSTR + (r0 + 32) * VSTR + ch * 16) = v1; } while (0)
#define ATT_BAR() asm volatile("s_waitcnt lgkmcnt(0)\n\ts_barrier" ::: "memory")
    const unsigned long long* mrow = (const unsigned long long*)(BITS + qrow * BW);
    ATT_LOAD(0, kA0, kA1, vA0, vA1); ATT_LOAD(1, kB0, kB1, vB0, vB1);
    ATT_STORE(0, kA0, kA1, vA0, vA1);
    if (NT > 2) ATT_LOAD(2, kA0, kA1, vA0, vA1);
    unsigned long long mwA = mrow[0], mwB = mrow[1];
    ATT_BAR();
    float mrun = 0.f, lrun = 0.f; f32x16 o0 = {}, o1 = {}, negm = {};
    const int qq4 = (lane & 15) >> 2, pp = lane & 3, blk = (lane >> 4) & 1;
    for (int tile2 = 0; tile2 < NT; tile2 += 2) {
#pragma unroll
        for (int half = 0; half < 2; ++half) {
            const int tile = tile2 + half; const int buf = half;
            const unsigned long long mw = half ? mwB : mwA;
            if (64 * tile <= qw0 + 31 && qw0 < LV) {
            f32x16 s0 = negm, s1 = negm;
            const LAS unsigned char* kb = Ks + buf * 64 * KSTR + n * KSTR + hl * 128 + hh * 16;
            bf16x8 kf0[4], kf1[4];
#pragma unroll
            for (int ks = 0; ks < 4; ++ks) { kf0[ks] = *(const LAS bf16x8*)(kb + ks * 32); kf1[ks] = *(const LAS bf16x8*)(kb + 32 * KSTR + ks * 32); }
            __builtin_amdgcn_sched_barrier(0);
#pragma unroll
            for (int ks = 0; ks < 4; ++ks) {
                s0 = __builtin_amdgcn_mfma_f32_32x32x16_bf16(kf0[ks], qf[ks], s0, 0, 0, 0);
                s1 = __builtin_amdgcn_mfma_f32_32x32x16_bf16(kf1[ks], qf[ks], s1, 0, 0, 0);
            }
            const LAS unsigned char* vb = Vs + buf * 64 * VSTR + (4 * hh + qq4) * VSTR + (hl * 64 + 16 * blk + 4 * pp) * 2;
            s16x4 vlo[2][2][2], vhi[2][2][2];
#pragma unroll
            for (int mb = 0; mb < 2; ++mb)
#pragma unroll
                for (int ks = 0; ks < 2; ++ks)
#pragma unroll
                    for (int db = 0; db < 2; ++db) {
                        const LAS unsigned char* vk = vb + (32 * mb + 16 * ks) * VSTR;
                        vlo[mb][ks][db] = __builtin_bit_cast(s16x4, __builtin_amdgcn_ds_read_tr16_b64_v4i16((LAS v4i16_t*)(vk + db * 64)));
                        vhi[mb][ks][db] = __builtin_bit_cast(s16x4, __builtin_amdgcn_ds_read_tr16_b64_v4i16((LAS v4i16_t*)(vk + 8 * VSTR + db * 64)));
                    }
            __builtin_amdgcn_sched_barrier(0);
            float mxa = fmaxf(s0[0], s1[0]), mxb = fmaxf(s0[1], s1[1]);
#pragma unroll
            for (int r = 2; r < 16; r += 2) { mxa = vmax3(mxa, s0[r], s1[r]); mxb = vmax3(mxb, s0[r + 1], s1[r + 1]); }
            float mx = fmaxf(mxa, mxb);
            if (__any(mx > 6.0f)) {
                mx = fmaxf(mx, __shfl_xor(mx, 32));
                const float dl = fmaxf(mx, 0.f);
                mrun += dl;
                const float alpha = __builtin_amdgcn_exp2f(-dl);
                lrun *= alpha;
#pragma unroll
                for (int r = 0; r < 16; ++r) { s0[r] -= dl; s1[r] -= dl; o0[r] *= alpha; o1[r] *= alpha; negm[r] = -mrun; }
            }
            const int wl = (int)((unsigned)mw >> (4 * hh)), wh = (int)((unsigned)(mw >> 32) >> (4 * hh));
            f32x2 ps2 = {0.f, 0.f};
#pragma unroll
            for (int r = 0; r < 16; r += 2) {
                const int c0b = (r & 3) + 8 * (r >> 2), c1b = ((r + 1) & 3) + 8 * ((r + 1) >> 2);
                const float a0 = __uint_as_float(__float_as_uint(__builtin_amdgcn_exp2f(s0[r])) & bfe1(wl, c0b));
                const float a1 = __uint_as_float(__float_as_uint(__builtin_amdgcn_exp2f(s0[r + 1])) & bfe1(wl, c1b));
                const float b0 = __uint_as_float(__float_as_uint(__builtin_amdgcn_exp2f(s1[r])) & bfe1(wh, c0b));
                const float b1 = __uint_as_float(__float_as_uint(__builtin_amdgcn_exp2f(s1[r + 1])) & bfe1(wh, c1b));
                s0[r] = a0; s0[r + 1] = a1; s1[r] = b0; s1[r + 1] = b1;
                ps2 += (f32x2){a0, a1}; ps2 += (f32x2){b0, b1};
            }
            lrun += ps2[0] + ps2[1];
            __builtin_amdgcn_sched_barrier(0);
#pragma unroll
            for (int mb = 0; mb < 2; ++mb)
#pragma unroll
                for (int ks = 0; ks < 2; ++ks) {
                    bf16x8 pf;
                    { u32x4 pw;
                      if (mb == 0) { pw.x = pk2(s0[8 * ks + 0], s0[8 * ks + 1]); pw.y = pk2(s0[8 * ks + 2], s0[8 * ks + 3]); pw.z = pk2(s0[8 * ks + 4], s0[8 * ks + 5]); pw.w = pk2(s0[8 * ks + 6], s0[8 * ks + 7]); }
                      else         { pw.x = pk2(s1[8 * ks + 0], s1[8 * ks + 1]); pw.y = pk2(s1[8 * ks + 2], s1[8 * ks + 3]); pw.z = pk2(s1[8 * ks + 4], s1[8 * ks + 5]); pw.w = pk2(s1[8 * ks + 6], s1[8 * ks + 7]); }
                      pf = __builtin_bit_cast(bf16x8, pw); }
#pragma unroll
                    for (int db = 0; db < 2; ++db) {
                        const s16x4 lo = vlo[mb][ks][db], hi = vhi[mb][ks][db];
                        const bf16x8 vf = (bf16x8){lo[0], lo[1], lo[2], lo[3], hi[0], hi[1], hi[2], hi[3]};
                        if (db == 0) o0 = __builtin_amdgcn_mfma_f32_32x32x16_bf16(vf, pf, o0, 0, 0, 0);
                        else         o1 = __builtin_amdgcn_mfma_f32_32x32x16_bf16(vf, pf, o1, 0, 0, 0);
                    }
                }
            }
            if (half == 0) {
                ATT_STORE(1, kB0, kB1, vB0, vB1);
                if (tile + 3 < NT) ATT_LOAD(tile + 3, kB0, kB1, vB0, vB1);
                if (tile + 2 < NT) mwA = mrow[tile + 2];
            } else {
                if (tile + 1 < NT) { ATT_STORE(0, kA0, kA1, vA0, vA1); if (tile + 3 < NT) ATT_LOAD(tile + 3, kA0, kA1, vA0, vA1); }
                if (tile + 2 < NT) mwB = mrow[tile + 2];
            }
            ATT_BAR();
        }
    }
#undef ATT_LOAD
#undef ATT_STORE
#undef ATT_BAR
    lrun += __shfl_xor(lrun, 32);
    const float inv = 1.0f / lrun;
#pragma unroll
    for (int db = 0; db < 2; ++db)
#pragma unroll
        for (int g4 = 0; g4 < 4; ++g4) {
            const int d0 = 32 * db + 8 * g4 + 4 * hh;
            const u32x2 z = *(const u32x2*)(ZA + qrow * 512 + h * 64 + d0);
            float v0, v1, v2, v3;
            if (db == 0) { v0 = o0[4 * g4]; v1 = o0[4 * g4 + 1]; v2 = o0[4 * g4 + 2]; v3 = o0[4 * g4 + 3]; } else { v0 = o1[4 * g4]; v1 = o1[4 * g4 + 1]; v2 = o1[4 * g4 + 2]; v3 = o1[4 * g4 + 3]; }
            u32x2 w; w.x = pk2(v0 * inv * bflo(z.x), v1 * inv * bfhi(z.x)); w.y = pk2(v2 * inv * bflo(z.y), v3 * inv * bfhi(z.y));
            *(u32x2*)(YMIX + qrow * 1024 + 512 + h * 64 + d0) = w;
        }
}

__device__ __forceinline__ void ln_phase(const Params& p, int l, int wave, int lane) {
    const int gw = blockIdx.x * 8 + wave, NGW = gridDim.x * 8;
    bf16_t* HB = (bf16_t*)(p.ws + WS_HB); float* METAH = (float*)(p.ws + WS_METAH);
    const float* G = p.post_g + l * 1024; const float* Bv = p.post_b + l * 1024;
    f32x4 gg[4], bb[4];
#pragma unroll
    for (int j = 0; j < 4; ++j) { gg[j] = *((const f32x4*)G + lane + 64 * j); bb[j] = *((const f32x4*)Bv + lane + 64 * j); }
    constexpr int NGRP = NB * LV / 4;
    for (int g = gw; g < NGRP; g += NGW) {
        const int v0 = 4 * g; const int b = v0 / LV, t0 = v0 - b * LV;
        float* hp[4]; f32x4 v[4][4]; float s[4], q[4];
#pragma unroll
        for (int i = 0; i < 4; ++i) { const int t = t0 + i; hp[i] = (t < NMETA) ? (METAH + (size_t)(b * NMETA + t) * 1024) : (p.out + ((size_t)b * SEQ + (t - NMETA)) * 1024); }
#pragma unroll
        for (int i = 0; i < 4; ++i) { s[i] = 0.f;
#pragma unroll
            for (int j = 0; j < 4; ++j) { v[i][j] = *((const f32x4*)hp[i] + lane + 64 * j); } }
#pragma unroll
        for (int i = 0; i < 4; ++i)
#pragma unroll
            for (int j = 0; j < 4; ++j) s[i] += (v[i][j][0] + v[i][j][1]) + (v[i][j][2] + v[i][j][3]);
#pragma unroll
        for (int o = 1; o < 64; o <<= 1) {
#pragma unroll
            for (int i = 0; i < 4; ++i) s[i] += __shfl_xor(s[i], o); }
#pragma unroll
        for (int i = 0; i < 4; ++i) { const float mean = s[i] * (1.f / 1024.f); s[i] = mean; q[i] = 0.f;
#pragma unroll
            for (int j = 0; j < 4; ++j) { v[i][j] = v[i][j] - mean; q[i] += (v[i][j][0] * v[i][j][0] + v[i][j][1] * v[i][j][1]) + (v[i][j][2] * v[i][j][2] + v[i][j][3] * v[i][j][3]); } }
#pragma unroll
        for (int o = 1; o < 64; o <<= 1) {
#pragma unroll
            for (int i = 0; i < 4; ++i) q[i] += __shfl_xor(q[i], o); }
#pragma unroll
        for (int i = 0; i < 4; ++i) {
            const float rstd = 1.0f / sqrtf(q[i] * (1.f / 1024.f) + LN_EPS);
            const size_t r = (size_t)(b * LP + t0 + i);
            u32x2* o = (u32x2*)(HB + r * 1024) + lane;
            if (lane == 0) { f32x2 st; st[0] = s[i]; st[1] = rstd; *(f32x2*)((float*)(p.ws + WS_STAT) + r * 2) = st; }
#pragma unroll
            for (int j = 0; j < 4; ++j) { const f32x4 y = v[i][j] * rstd * gg[j] + bb[j]; if (l == DEPTH - 1) *((f32x4*)hp[i] + lane + 64 * j) = y;
                u32x2 w; w.x = pk2(y[0], y[1]); w.y = pk2(y[2], y[3]); o[64 * j] = w; }
        }
    }
}

#define XB_TMO      128
#define XB_XCNT(j)  (256  + 64 * (j))
#define XB_XSUB(j)  (1280 + 64 * (j))
#define XB_XGEN(j)  (2304 + 64 * (j))
#define XB_TOP      3328
#define XB_TOPGEN   3392
#define XCD_BAR_WORDS 3456
#define XB_SPIN_CAP (1u << 18)

__device__ __forceinline__ unsigned xb_ld(unsigned* p)              { return __hip_atomic_load(p, __ATOMIC_RELAXED, __HIP_MEMORY_SCOPE_AGENT); }
__device__ __forceinline__ unsigned xb_add(unsigned* p, unsigned v) { return __hip_atomic_fetch_add(p, v, __ATOMIC_RELAXED, __HIP_MEMORY_SCOPE_AGENT); }
__device__ __forceinline__ unsigned xb_xcc_id() { return (unsigned)__builtin_amdgcn_s_getreg((3 << 11) | 20) & 0xFu; }
#define XB_SPIN(cond, bar) do { unsigned _sp = 0; while (cond) { __builtin_amdgcn_s_sleep(1); \
    if ((++_sp & 255u) == 0u) { if (xb_ld(&(bar)[XB_TMO])) break; if (_sp > XB_SPIN_CAP) { atomicAdd(&(bar)[XB_TMO], 1u); break; } } } } while (0)

struct XcdBarrier {
    unsigned* bar; unsigned x;
    volatile LAS unsigned* st;
};

__device__ __forceinline__ XcdBarrier xcd_barrier_post(unsigned* bar, volatile LAS unsigned* st) {
    XcdBarrier b; b.bar = bar; b.x = xb_xcc_id(); b.st = st;
    if (threadIdx.x == 0) (void)xb_add(&bar[XB_XCNT(b.x)], 1u);
    return b;
}
__device__ __forceinline__ void xcd_barrier_complete(unsigned* bar, unsigned x, unsigned& nloc, unsigned& nx) {
    const unsigned G = gridDim.x * gridDim.y * gridDim.z;
    unsigned sum, cnt, mine, sp = 0u;
    for (;;) {
        sum = 0u; cnt = 0u; mine = 0u;
#pragma unroll
        for (unsigned j = 0; j < 16; ++j) { const unsigned c = xb_ld(&bar[XB_XCNT(j)]); sum += c; cnt += (c > 0u) ? 1u : 0u; mine = (j == x) ? c : mine; }
        if (sum == G) break;
        __builtin_amdgcn_s_sleep(1);
        if ((++sp & 255u) == 0u) { if (xb_ld(&bar[XB_TMO])) break; if (sp > XB_SPIN_CAP) { atomicAdd(&bar[XB_TMO], 1u); break; } }
    }
    nloc = mine > 0u ? mine : 1u; nx = cnt > 0u ? cnt : 1u;
}

__device__ __forceinline__ void xcd_barrier(const XcdBarrier& b) {
    asm volatile("s_waitcnt vmcnt(0)" ::: "memory");
    __syncthreads();
    if (threadIdx.x == 0) {
        unsigned* bar = b.bar;
        __builtin_amdgcn_s_waitcnt(0);
        unsigned nloc = b.st[0], nx = b.st[1];
        if (nloc == 0u) { xcd_barrier_complete(bar, b.x, nloc, nx); b.st[0] = nloc; b.st[1] = nx; }
        const unsigned old = xb_add(&bar[XB_XSUB(b.x)], 1u);
        const unsigned gen = old / nloc;
        if (old + 1u == (gen + 1u) * nloc) {
            __builtin_amdgcn_fence(__ATOMIC_RELEASE, "agent");
            asm volatile("s_waitcnt vmcnt(0)" ::: "memory");
            const unsigned og = xb_add(&bar[XB_TOP], 1u);
            const unsigned tg = og / nx;
            if (og + 1u == (tg + 1u) * nx) xb_add(&bar[XB_TOPGEN], 1u);
            else XB_SPIN(xb_ld(&bar[XB_TOPGEN]) == tg, bar);
            __builtin_amdgcn_fence(__ATOMIC_ACQUIRE, "agent");
            xb_add(&bar[XB_XGEN(b.x)], 1u);
            asm volatile("s_waitcnt vmcnt(0)" ::: "memory");
        } else {
            XB_SPIN(xb_ld(&bar[XB_XGEN(b.x)]) == gen, bar);
            __builtin_amdgcn_fence(__ATOMIC_ACQUIRE, "agent");
            asm volatile("s_waitcnt vmcnt(0)" ::: "memory");
        }
    }
    __syncthreads();
}

#ifndef REP_P2
#define REP_P2 1
#endif
#ifndef REP_IDX
#define REP_IDX 1
#endif
#ifndef REP_CONV
#define REP_CONV 1
#endif
#ifndef REP_P0
#define REP_P0 1
#endif
#ifndef REP_SYNC
#define REP_SYNC 0
#endif
#ifndef REP_P3
#define REP_P3 1
#endif
#ifndef REP_G1
#define REP_G1 1
#endif
__global__ void __launch_bounds__(512, 2) fwd_megakernel(Params p) {
    extern __shared__ __attribute__((aligned(16))) unsigned char lds_raw[];
    cg::grid_group grid = cg::this_grid();
    LAS unsigned char* lds = (LAS unsigned char*)lds_raw;
    const int tid = threadIdx.x, lane = tid & 63, wave = __builtin_amdgcn_readfirstlane(tid >> 6);
    const int G = gridDim.x, bx = blockIdx.x;
    unsigned char* ws = p.ws;
    bf16_t* HB = (bf16_t*)(ws + WS_HB);
    bf16_t *U = (bf16_t*)(ws + WS_U), *ZC = (bf16_t*)(ws + WS_ZC), *Q = (bf16_t*)(ws + WS_Q), *K = (bf16_t*)(ws + WS_K), *V = (bf16_t*)(ws + WS_V),
           *ZA = (bf16_t*)(ws + WS_ZA), *QI = (bf16_t*)(ws + WS_QI), *KI = (bf16_t*)(ws + WS_KI), *YMIX = (bf16_t*)(ws + WS_YMIX);
    float* WI = (float*)(ws + WS_WI); unsigned* BITS = (unsigned*)(ws + WS_BITS); float* METAH = (float*)(ws + WS_METAH);
    const float* cosT = (const float*)(ws + WS_COS); const float* sinT = (const float*)(ws + WS_SIN);

    if (tid < 16) ((LAS unsigned*)(lds + LDS_BYTES - 64))[tid] = 0u;
    __syncthreads();
    const XcdBarrier xbar = xcd_barrier_post((unsigned*)(ws + WS_BAR), (volatile LAS unsigned*)(lds + LDS_BYTES - 64));
#define GSYNC() xcd_barrier(xbar)
    if (p.ws == nullptr) grid.sync();
#ifndef NO_P0
    for (int rp_ = 0; rp_ < REP_P0; ++rp_) p0_prologue(p, lds, wave, lane);
#endif
    GSYNC();
    for (int rs_ = 0; rs_ < REP_SYNC; ++rs_) GSYNC();

#define LAUNDER() int tid_ = tid, wave_ = wave; asm volatile("" : "+v"(tid_)); asm volatile("" : "+s"(wave_)); const int lane_ = tid_ & 63; (void)lane_; (void)wave_
#pragma unroll 1
    for (int l = 0; l < DEPTH; ++l) {
#ifndef NO_G1
        for (int rep_ = 0; rep_ < REP_G1; ++rep_) {
            pg8::Gemm g{HB, (const bf16_t*)(ws + WS_WIN) + (size_t)l * NPAD * 1024, NR, NPAD, 1024};
            pg8::StaticOrder S; S.init(NR, NPAD, G, bx);
            EpiIn E{U, ZC, Q, K, V, ZA, QI, KI, WI, cosT, sinT};
            pg8::gemm_phase<EpiIn, pg8::StaticOrder, true, true>(lds, g, S, E);
        }
#endif
        GSYNC();
#ifndef NO_P2
        for (int rep_ = 0; rep_ < REP_P2; ++rep_) {
            LAUNDER();
            constexpr int NITEM = NB * (LV / 8);
            for (int ri_ = 0; ri_ < REP_IDX; ++ri_)
            for (int k = 0; k * G < NITEM; ++k) {
                const int idx = (k & 1) ? (k * G + (G - 1 - bx)) : (k * G + bx);
                if (idx < NITEM) { const int g = (LV / 8 - 1) - idx / NB, b = idx % NB; idx_item(b, g, QI, KI, WI, BITS, lds, tid_, wave_, lane_); }
            }
            constexpr int NCT = NB * (LP / 32);
            for (int rc_ = 0; rc_ < REP_CONV; ++rc_)
            for (int ct = (G - 1 - bx); ct < NCT; ct += G) {
                const int b = ct / (LP / 32), ti = ct - b * (LP / 32);
                if (32 * ti >= LV) continue;
                conv_tile(b, ti, U, ZC, p.conv_w + (size_t)l * 31 * 512, p.conv_b + l * 512, p.conv_ln_g + l * 512, p.conv_ln_b + l * 512, YMIX, (LAS float*)lds, tid_, wave_, lane_);
            }
        }
#endif
        GSYNC();
#ifndef NO_P3
        for (int rep_ = 0; rep_ < REP_P3; ++rep_) {
            LAUNDER();
            constexpr int NU = NB * 4 * (LP / 128);
            for (int k = 0; k * G < NU; ++k) {
                const int idx = (k & 1) ? (k * G + (G - 1 - bx)) : (k * G + bx);
                if (idx < NU) { const int qb = (LP / 128 - 1) - idx / 32, bh = idx % 32; attn_unit(bh >> 2, bh & 3, qb, Q, K, V, ZA, BITS, YMIX, lds, tid_, wave_, lane_); }
            }
        }
#endif
        GSYNC();
#ifndef NO_G2
        {
            pg8::Gemm g{YMIX, (const bf16_t*)(ws + WS_WOUT) + (size_t)l * 1024 * 1024, NR, 1024, 1024};
            pg8::StaticOrder S; S.init(NR, 1024, G, bx);
            EpiOut E{l == 0 ? p.x : p.out, l == 0 ? p.meta : METAH, l == 0 ? 0 : NMETA * 1024, p.out, METAH,
                     l == 0 ? (const float*)nullptr : (const float*)(ws + WS_STAT), p.post_g + (l > 0 ? l - 1 : 0) * 1024, p.post_b + (l > 0 ? l - 1 : 0) * 1024, (float*)(ws + WS_DUMP)};
            pg8::gemm_phase<EpiOut, pg8::StaticOrder, true, true>(lds, g, S, E);
        }
#endif
        GSYNC();
#ifndef NO_P4
        { LAUNDER(); ln_phase(p, l, wave_, lane_); }
#endif
        GSYNC();
    }
}

extern "C" void kernel_launch(void* const* d_in, const int* in_sizes, int n_in, void* d_out, int out_size, void* d_ws, size_t ws_size, hipStream_t stream) {
    static int grid_blocks = 0;
    if (grid_blocks == 0) {
        if (ws_size < WS_END) { fprintf(stderr, "kernel_launch: workspace too small: %zu < %zu\n", ws_size, (size_t)WS_END); grid_blocks = -1; return; }
        int dev = 0, cus = 0, per_cu = 0;
        hipGetDevice(&dev);
        hipDeviceGetAttribute(&cus, hipDeviceAttributeMultiprocessorCount, dev);
        if (hipFuncSetAttribute((const void*)fwd_megakernel, hipFuncAttributeMaxDynamicSharedMemorySize, LDS_BYTES) != hipSuccess) { fprintf(stderr, "kernel_launch: hipFuncSetAttribute failed\n"); }
        if (hipOccupancyMaxActiveBlocksPerMultiprocessor(&per_cu, (const void*)fwd_megakernel, 512, LDS_BYTES) != hipSuccess || per_cu < 1) { fprintf(stderr, "kernel_launch: occupancy query gave %d\n", per_cu); per_cu = 1; }
        (void)hipGetLastError();
        if (per_cu > 1) per_cu = 1;
        grid_blocks = cus * per_cu;
    }
    if (grid_blocks < 0) return;
    Params p{};
    p.x = (const float*)d_in[0]; p.meta = (const float*)d_in[1]; p.w_in = (const float*)d_in[2]; p.conv_w = (const float*)d_in[3]; p.conv_b = (const float*)d_in[4];
    p.conv_ln_g = (const float*)d_in[5]; p.conv_ln_b = (const float*)d_in[6]; p.w_out = (const float*)d_in[7]; p.post_g = (const float*)d_in[8]; p.post_b = (const float*)d_in[9];
    p.out = (float*)d_out; p.ws = (unsigned char*)d_ws;
    void* args[] = {&p};
    if (hipMemsetAsync((char*)d_ws + WS_BAR, 0, 16384, stream) != hipSuccess) { fprintf(stderr, "kernel_launch: hipMemsetAsync of the barrier words failed\n"); return; }
    hipError_t e = hipLaunchCooperativeKernel((const void*)fwd_megakernel, dim3(grid_blocks), dim3(512), args, LDS_BYTES, stream);
    if (e != hipSuccess) fprintf(stderr, "cooperative launch failed: %s (grid %d)\n", hipGetErrorString(e), grid_blocks);
}
```

```cpp
#include <hip/hip_runtime.h>
#include <hip/hip_cooperative_groups.h>
#include <cstdio>
#include <cstdint>
namespace cg = cooperative_groups;
namespace pg8 {
#define PG8_LAS __attribute__((address_space(3)))
typedef unsigned short bf16_t;
typedef short bf16x8 __attribute__((ext_vector_type(8)));
typedef float f32x4 __attribute__((ext_vector_type(4)));
typedef unsigned u32x4 __attribute__((ext_vector_type(4)));
constexpr int BM = 256, BK = 64, HALF = 128, HTB = HALF * BK * 2  , STAGE_BYTES = 8 * HTB, NXCD = 8, WGM = 8;

__host__ __device__ __forceinline__ int lds_byte(int r, int c) { const int st = (r >> 4) * 2 + (c >> 5), rr = r & 15, cc = c & 31, ob = rr * 64 + cc * 2; return st * 1024 + (ob ^ (((ob >> 9) & 1) << 5)); }
__host__ __device__ __forceinline__ void stage_rc(int b, int& R, int& C) { const int st = b / 1024, sb = b % 1024, swz = sb ^ (((sb >> 9) & 1) << 5); R = (st >> 1) * 16 + swz / 64; C = (st & 1) * 32 + (swz % 64) / 2; }
__host__ __device__ __forceinline__ int perm32(int rho) { const int n = rho >> 4, i = rho & 15; return 8 * (i >> 2) + 4 * n + (i & 3); }

struct Unit { int pm, pn; };
struct Gemm { const bf16_t* A; const bf16_t* Bt; int M, N, K; };

struct StaticOrder {
    int nM, nN, nwg, G, c;
    __host__ __device__ void init(int M, int N, int G_, int c_) { nM = M / BM; nN = N / BM; nwg = nM * nN; G = G_; c = c_; }
    __host__ __device__ bool next(int i, Unit& u) const {
        const long L = (long)i * G + c; if (L >= nwg) return false;
        int wgid = (int)L; { const int q = nwg / NXCD, r = nwg % NXCD, xcd = wgid % NXCD, off = wgid / NXCD; wgid = (xcd < r ? xcd * (q + 1) : r * (q + 1) + (xcd - r) * q) + off; }
        const int nig = WGM * nN, gid = wgid / nig, fm = gid * WGM, gsz = (nM - fm) < WGM ? (nM - fm) : WGM;
        u.pm = fm + ((wgid % nig) % gsz); u.pn = (wgid % nig) / gsz; return true;
    }
    __device__ __forceinline__ void a_ready(const Unit&) const {}
    __device__ __forceinline__ void done(const Unit&) const {}
};
template <class Epi, class Sched, bool ALIGN_EPI = false, bool SP2 = false>
__device__ __forceinline__ void gemm_phase(PG8_LAS unsigned char* lds, const Gemm g, const Sched& S, const Epi& E) {
    int tid = threadIdx.x; asm volatile("" : "+v"(tid)); const int wid = __builtin_amdgcn_readfirstlane(tid >> 6), lane = tid & 63, wr = wid >> 2, wc = wid & 3, fr = lane & 15, fq = lane >> 4;
    const int K = g.K, nt = K / BK;
    unsigned voffA[2], voffB[2];
#pragma unroll
    for (int i = 0; i < 2; ++i) { int R, C; stage_rc(tid * 16 + i * 8192, R, C); const int Rb = Epi::PERM ? ((R & ~31) + perm32(R & 31)) : R;
        voffA[i] = (unsigned)(R * K + C) * 2u; voffB[i] = (unsigned)(Rb * K + C) * 2u; }
    const size_t kstep = (size_t)(BK * 2);
    const size_t hstep = (size_t)HALF * K * 2;
    const size_t tstep = 2 * hstep;
    const unsigned ldsw = (unsigned)wid * 1024u;
    const int aoff = lds_byte(wr * 64 + fr, fq * 8), boff = lds_byte(wc * 32 + fr, fq * 8);
#define PG8_SA(b, h) (((b) * 2 + (h)) * HTB)
#define PG8_SB(b, h) ((4 + (b) * 2 + (h)) * HTB)
#define PG8_STAGE(bufoff, gbase, voff) do { _Pragma("unroll") for (int _i = 0; _i < 2; ++_i) \
        __builtin_amdgcn_global_load_lds((const unsigned*)((const char*)(gbase) + (voff)[_i]), (PG8_LAS unsigned*)(lds + (bufoff) + ldsw + _i * 8192), 16, 0, 0); } while (0)
#define PG8_LDA(dst, b, h) do { _Pragma("unroll") for (int m = 0; m < 4; ++m) _Pragma("unroll") for (int k = 0; k < 2; ++k) dst[m][k] = *(const PG8_LAS bf16x8*)(lds + PG8_SA(b, h) + aoff + m * 2048 + k * 1024); } while (0)
#define PG8_LDB(dst, b, h) do { _Pragma("unroll") for (int n = 0; n < 2; ++n) _Pragma("unroll") for (int k = 0; k < 2; ++k) dst[n][k] = *(const PG8_LAS bf16x8*)(lds + PG8_SB(b, h) + boff + n * 2048 + k * 1024); } while (0)
#define PG8_MMA(ai, bj, At, Bt) do { __builtin_amdgcn_s_setprio(1); _Pragma("unroll") for (int m = 0; m < 4; ++m) _Pragma("unroll") for (int n = 0; n < 2; ++n) _Pragma("unroll") for (int k = 0; k < 2; ++k) \
        acc[ai][bj][m][n] = __builtin_amdgcn_mfma_f32_16x16x32_bf16(Bt[n][k], At[m][k], acc[ai][bj][m][n], 0, 0, 0); __builtin_amdgcn_s_setprio(0); } while (0)
#define PG8_WAIT_V(n) asm volatile("s_waitcnt vmcnt(" #n ")" ::: "memory")
#define PG8_WAIT_L(n) asm volatile("s_waitcnt lgkmcnt(" #n ")" ::: "memory")
#define PG8_BAR __builtin_amdgcn_s_barrier()
#define PG8_SCHED __builtin_amdgcn_sched_barrier(0)
    Unit cur, nxt; int ui = 0;
    if (!S.next(0, cur)) return;
    f32x4 acc[2][2][4][2];
#pragma unroll
    for (int a = 0; a < 2; ++a)
#pragma unroll
        for (int b = 0; b < 2; ++b)
#pragma unroll
            for (int m = 0; m < 4; ++m)
#pragma unroll
                for (int n = 0; n < 2; ++n) acc[a][b][m][n] = (f32x4){0.f, 0.f, 0.f, 0.f};
    bf16x8 At[4][2], B0[2][2], B1[2][2];
    const char* cA = (const char*)g.A + (size_t)cur.pm * tstep; const char* cB = (const char*)g.Bt + (size_t)cur.pn * tstep;
    S.a_ready(cur);
    if constexpr (SP2) {
        PG8_STAGE(PG8_SB(0, 0), cB, voffB); PG8_STAGE(PG8_SB(0, 1), cB + hstep, voffB); PG8_STAGE(PG8_SA(0, 0), cA, voffA); PG8_STAGE(PG8_SA(0, 1), cA + hstep, voffA);
        if (wr == 1) PG8_BAR;
        PG8_WAIT_V(2); PG8_BAR;
        PG8_STAGE(PG8_SB(1, 0), cB + kstep, voffB); PG8_STAGE(PG8_SA(1, 0), cA + kstep, voffA); PG8_STAGE(PG8_SB(1, 1), cB + hstep + kstep, voffB);
        PG8_WAIT_V(6); PG8_BAR;
    } else {
        PG8_STAGE(PG8_SB(0, 0), cB, voffB); PG8_STAGE(PG8_SA(0, 0), cA, voffA); PG8_STAGE(PG8_SB(0, 1), cB + hstep, voffB); PG8_STAGE(PG8_SA(0, 1), cA + hstep, voffA);
        if (wr == 1) PG8_BAR;
        PG8_WAIT_V(4); PG8_BAR;
        PG8_STAGE(PG8_SB(1, 0), cB + kstep, voffB); PG8_STAGE(PG8_SA(1, 0), cA + kstep, voffA); PG8_STAGE(PG8_SB(1, 1), cB + hstep + kstep, voffB);
        PG8_WAIT_V(6); PG8_BAR;
    }
    for (;;) {
        const bool has_next = S.next(ui + 1, nxt);
        const char* nA = has_next ? (const char*)g.A + (size_t)nxt.pm * tstep : cA; const char* nB = has_next ? (const char*)g.Bt + (size_t)nxt.pn * tstep : cB;
        for (int t = 0; t < nt; t += 2) {
            const bool last = (t == nt - 2);
            const char* a1 = cA + (size_t)(t + 1) * kstep;
            const char* a2 = last ? nA : cA + (size_t)(t + 2) * kstep; const char* b2 = last ? nB : cB + (size_t)(t + 2) * kstep;
            const char* a3 = a2 + kstep; const char* b3 = b2 + kstep;
            if (last && has_next) S.a_ready(nxt);
            if constexpr (SP2) {
            PG8_LDB(B0, 0, 0); PG8_LDB(B1, 0, 1); PG8_SCHED; PG8_LDA(At, 0, 0); PG8_STAGE(PG8_SA(1, 1), a1 + hstep, voffA);
            PG8_WAIT_V(8); PG8_WAIT_L(0); PG8_BAR; PG8_MMA(0, 0, At, B0); PG8_MMA(0, 1, At, B1); PG8_BAR; PG8_SCHED;
            PG8_LDA(At, 0, 1); PG8_STAGE(PG8_SB(0, 0), b2, voffB); PG8_STAGE(PG8_SB(0, 1), b2 + hstep, voffB); PG8_STAGE(PG8_SA(0, 0), a2, voffA);
            PG8_WAIT_V(8); PG8_WAIT_L(0); PG8_BAR; PG8_MMA(1, 0, At, B0); PG8_MMA(1, 1, At, B1); PG8_BAR; PG8_SCHED;
            PG8_LDB(B0, 1, 0); PG8_LDB(B1, 1, 1); PG8_SCHED; PG8_LDA(At, 1, 0); PG8_STAGE(PG8_SA(0, 1), a2 + hstep, voffA);
            PG8_WAIT_V(8); PG8_WAIT_L(0); PG8_BAR; PG8_MMA(0, 0, At, B0); PG8_MMA(0, 1, At, B1); PG8_BAR; PG8_SCHED;
            PG8_LDA(At, 1, 1); PG8_STAGE(PG8_SB(1, 0), b3, voffB); PG8_STAGE(PG8_SB(1, 1), b3 + hstep, voffB); PG8_STAGE(PG8_SA(1, 0), a3, voffA);
            PG8_WAIT_V(8); PG8_WAIT_L(0); PG8_BAR; PG8_MMA(1, 0, At, B0); PG8_MMA(1, 1, At, B1); PG8_BAR; PG8_SCHED;
            } else {
            PG8_LDB(B0, 0, 0); PG8_SCHED; PG8_LDA(At, 0, 0); PG8_STAGE(PG8_SA(1, 1), a1 + hstep, voffA);
            PG8_WAIT_L(8); PG8_BAR; PG8_WAIT_L(0); PG8_MMA(0, 0, At, B0); PG8_BAR; PG8_SCHED;
            PG8_LDB(B1, 0, 1); PG8_STAGE(PG8_SB(0, 0), b2, voffB);
            PG8_BAR; PG8_WAIT_L(0); PG8_MMA(0, 1, At, B1); PG8_BAR;
            PG8_LDA(At, 0, 1); PG8_STAGE(PG8_SA(0, 0), a2, voffA);
            PG8_BAR; PG8_WAIT_L(0); PG8_MMA(1, 0, At, B0); PG8_BAR; PG8_SCHED;
            PG8_STAGE(PG8_SB(0, 1), b2 + hstep, voffB);
            PG8_WAIT_V(6); PG8_BAR; PG8_MMA(1, 1, At, B1); PG8_BAR;
            PG8_LDB(B0, 1, 0); PG8_SCHED; PG8_LDA(At, 1, 0); PG8_STAGE(PG8_SA(0, 1), a2 + hstep, voffA);
            PG8_WAIT_L(8); PG8_BAR; PG8_WAIT_L(0); PG8_MMA(0, 0, At, B0); PG8_BAR; PG8_SCHED;
            PG8_LDB(B1, 1, 1); PG8_STAGE(PG8_SB(1, 0), b3, voffB);
            PG8_BAR; PG8_WAIT_L(0); PG8_MMA(0, 1, At, B1); PG8_BAR;
            PG8_LDA(At, 1, 1); PG8_STAGE(PG8_SA(1, 0), a3, voffA);
            PG8_BAR; PG8_WAIT_L(0); PG8_MMA(1, 0, At, B0); PG8_BAR; PG8_SCHED;
            PG8_STAGE(PG8_SB(1, 1), b3 + hstep, voffB);
            PG8_WAIT_V(6); PG8_BAR; PG8_MMA(1, 1, At, B1); PG8_BAR;
            }
        }
        if constexpr (ALIGN_EPI) { if (wr == 0) PG8_BAR; }
        if constexpr (!Epi::AFTER_DRAIN) { E(acc, cur, wr, wc, fr, fq); S.done(cur); }
        if (!has_next) break;
#pragma unroll
        for (int a = 0; a < 2; ++a)
#pragma unroll
            for (int b = 0; b < 2; ++b)
#pragma unroll
                for (int m = 0; m < 4; ++m)
#pragma unroll
                    for (int n = 0; n < 2; ++n) acc[a][b][m][n] = (f32x4){0.f, 0.f, 0.f, 0.f};
        cur = nxt; cA = nA; cB = nB; ++ui;
        if constexpr (ALIGN_EPI) { if (wr == 1) PG8_BAR; }
    }
    PG8_WAIT_V(0);
    if constexpr (!ALIGN_EPI) { if (wr == 0) PG8_BAR; }
    PG8_BAR;
    if constexpr (Epi::AFTER_DRAIN) { E.fused(acc, cur, wr, wc, fr, fq, lds, wid, lane); S.done(cur); }
#undef PG8_SA
#undef PG8_SB
#undef PG8_STAGE
#undef PG8_LDA
#undef PG8_LDB
#undef PG8_MMA
#undef PG8_WAIT_V
#undef PG8_WAIT_L
#undef PG8_BAR
#undef PG8_SCHED
}
}

#define LAS __attribute__((address_space(3)))
typedef unsigned short bf16_t;
typedef short bf16x8 __attribute__((ext_vector_type(8)));
typedef short s16x4 __attribute__((ext_vector_type(4)));
typedef float f32x4 __attribute__((ext_vector_type(4)));
typedef float f32x2 __attribute__((ext_vector_type(2)));
typedef float f32x16 __attribute__((ext_vector_type(16)));
typedef unsigned u32x4 __attribute__((ext_vector_type(4)));
typedef unsigned u32x2 __attribute__((ext_vector_type(2)));
typedef __bf16 bf16x2_t __attribute__((ext_vector_type(2)));

constexpr int NB = 8, SEQ = 4096, DM = 1024, DEPTH = 4, NMETA = 16;
constexpr int LV = SEQ + NMETA;
constexpr int LP = 4224;
constexpr int NR = NB * LP;
constexpr int DIN = 4168, NPAD = 4352;
constexpr int BW = 132;
constexpr float LN_EPS = 1e-5f;
constexpr float DN_ALPHA = 1.681792830507429f;
constexpr float QSCALE = 0.125f * 1.4426950408889634f;
constexpr float IDX_W_SCALE = 0.35355339059327373f;
constexpr int SSTR = 4232;
constexpr int LDS_BYTES = 157696;

constexpr size_t al256(size_t x) { return (x + 255) & ~(size_t)255; }
constexpr size_t WS_BAR = 0;
constexpr size_t WS_COS = 16384;
constexpr size_t WS_SIN = WS_COS + al256((size_t)LP * 32 * 4);
constexpr size_t WS_WIN = WS_SIN + al256((size_t)LP * 32 * 4);
constexpr size_t WS_WOUT = WS_WIN + (size_t)DEPTH * NPAD * 1024 * 2;
constexpr size_t WS_HB = WS_WOUT + (size_t)DEPTH * 1024 * 1024 * 2;
constexpr size_t SZ512 = (size_t)NR * 512 * 2;
constexpr size_t WS_U = WS_HB + (size_t)NR * 1024 * 2;
constexpr size_t WS_ZC = WS_U + SZ512;
constexpr size_t WS_Q = WS_ZC + SZ512;
constexpr size_t WS_K = WS_Q + SZ512;
constexpr size_t WS_V = WS_K + SZ512;
constexpr size_t WS_ZA = WS_V + SZ512;
constexpr size_t WS_QI = WS_ZA + SZ512;
constexpr size_t WS_KI = WS_QI + SZ512;
constexpr size_t WS_WI = WS_KI + (size_t)NR * 64 * 2;
constexpr size_t WS_YMIX = WS_WI + (size_t)NR * 8 * 4;
constexpr size_t WS_BITS = WS_YMIX + (size_t)NR * 1024 * 2;
constexpr size_t WS_METAH = WS_BITS + (size_t)NR * BW * 4;
constexpr size_t WS_STAT = WS_METAH + (size_t)NB * NMETA * 1024 * 4;
constexpr size_t WS_DUMP = WS_STAT + (size_t)NR * 2 * 4;
constexpr size_t WS_END = WS_DUMP + 4096;

struct Params {
    const float* x; const float* meta; const float* w_in; const float* conv_w; const float* conv_b;
    const float* conv_ln_g; const float* conv_ln_b; const float* w_out; const float* post_g; const float* post_b;
    float* out; unsigned char* ws;
};

__device__ __forceinline__ unsigned pk2(float lo, float hi) { f32x2 v = {lo, hi}; bf16x2_t b = __builtin_convertvector(v, bf16x2_t); return __builtin_bit_cast(unsigned, b); }
__device__ __forceinline__ float bflo(unsigned w) { return __uint_as_float(w << 16); }
__device__ __forceinline__ float bfhi(unsigned w) { return __uint_as_float(w & 0xffff0000u); }
__device__ __forceinline__ float sigmoidf_(float x) { return __builtin_amdgcn_rcpf(1.0f + __expf(-x)); }
__device__ __forceinline__ float wave_sum(float v) {
#pragma unroll
    for (int o = 1; o < 64; o <<= 1) v += __shfl_xor(v, o);
    return v;
}

__device__ __forceinline__ int in_colmap(int c) {
    const int pn = c >> 8, w = c & 255;
    if (pn < 4) return (w < 128) ? (128 * pn + w) : (512 + 128 * pn + (w - 128));
    if (pn == 16) { if (w < 64) return 4096 + (w >> 1) + 32 * (w & 1); if (w < 72) return 4160 + (w - 64); return -1; }
    const int kind = (pn - 4) >> 1;
    const int base = 1024 + 512 * kind + 256 * (pn & 1);
    if (kind == 1 || kind == 2 || kind == 5) return base + 64 * (w >> 6) + ((w & 63) >> 1) + 32 * (w & 1);
    return base + w;
}

struct EpiIn {
    static constexpr bool PERM = true, AFTER_DRAIN = false;
    bf16_t *U, *ZC, *Q, *K, *V, *ZA, *QI, *KI; float* WI; const float* cosT; const float* sinT;
    __device__ __forceinline__ void operator()(const pg8::f32x4 (&acc)[2][2][4][2], const pg8::Unit& u, int wr, int wc, int fr, int fq) const {
        const int pn = u.pn;
        const int row0 = u.pm * 256 + wr * 64 + fr;
        const int w0 = wc * 32 + 8 * fq;
        if (pn < 4) {
#pragma unroll
            for (int ai = 0; ai < 2; ++ai)
#pragma unroll
                for (int m = 0; m < 4; ++m) {
                    const int r = row0 + ai * 128 + m * 16;
                    const pg8::f32x4 a0 = acc[ai][0][m][0], a1 = acc[ai][0][m][1], g0 = acc[ai][1][m][0], g1 = acc[ai][1][m][1];
                    u32x4 w;
                    w.x = pk2(a0[0] * sigmoidf_(g0[0]), a0[1] * sigmoidf_(g0[1])); w.y = pk2(a0[2] * sigmoidf_(g0[2]), a0[3] * sigmoidf_(g0[3]));
                    w.z = pk2(a1[0] * sigmoidf_(g1[0]), a1[1] * sigmoidf_(g1[1])); w.w = pk2(a1[2] * sigmoidf_(g1[2]), a1[3] * sigmoidf_(g1[3]));
                    *(u32x4*)(U + (size_t)r * 512 + pn * 128 + w0) = w;
                }
        } else if (pn == 16) {
            if (w0 < 64) {
                const int i0 = w0 >> 1;
#pragma unroll
                for (int ai = 0; ai < 2; ++ai)
#pragma unroll
                    for (int m = 0; m < 4; ++m) {
                        const int r = row0 + ai * 128 + m * 16; const int t = r % LP;
                        const f32x4 c4 = *(const f32x4*)(cosT + t * 32 + i0), s4 = *(const f32x4*)(sinT + t * 32 + i0);
                        const pg8::f32x4 v0 = acc[ai][0][m][0], v1 = acc[ai][0][m][1];
                        u32x4 w;
                        w.x = pk2(v0[0] * c4[0] - v0[1] * s4[0], v0[1] * c4[0] + v0[0] * s4[0]);
                        w.y = pk2(v0[2] * c4[1] - v0[3] * s4[1], v0[3] * c4[1] + v0[2] * s4[1]);
                        w.z = pk2(v1[0] * c4[2] - v1[1] * s4[2], v1[1] * c4[2] + v1[0] * s4[2]);
                        w.w = pk2(v1[2] * c4[3] - v1[3] * s4[3], v1[3] * c4[3] + v1[2] * s4[3]);
                        *(u32x4*)(KI + (size_t)r * 64 + w0) = w;
                    }
            } else if (w0 == 64) {
#pragma unroll
                for (int ai = 0; ai < 2; ++ai)
#pragma unroll
                    for (int m = 0; m < 4; ++m) {
                        const int r = row0 + ai * 128 + m * 16;
                        *(f32x4*)(WI + (size_t)r * 8) = acc[ai][0][m][0] * IDX_W_SCALE;
                        *(f32x4*)(WI + (size_t)r * 8 + 4) = acc[ai][0][m][1] * IDX_W_SCALE;
                    }
            }
        } else {
            const int kind = (pn - 4) >> 1;
            bf16_t* base = kind == 0 ? ZC : kind == 1 ? Q : kind == 2 ? K : kind == 3 ? V : kind == 4 ? ZA : QI;
            const int cb = (pn & 1) * 256 + w0;
            if (kind == 0 || kind == 4) {
#pragma unroll
                for (int ai = 0; ai < 2; ++ai)
#pragma unroll
                    for (int m = 0; m < 4; ++m) {
                        const int r = row0 + ai * 128 + m * 16;
#pragma unroll
                        for (int bj = 0; bj < 2; ++bj) {
                            const pg8::f32x4 v0 = acc[ai][bj][m][0], v1 = acc[ai][bj][m][1];
                            u32x4 w;
                            w.x = pk2(v0[0] * sigmoidf_(v0[0]), v0[1] * sigmoidf_(v0[1])); w.y = pk2(v0[2] * sigmoidf_(v0[2]), v0[3] * sigmoidf_(v0[3]));
                            w.z = pk2(v1[0] * sigmoidf_(v1[0]), v1[1] * sigmoidf_(v1[1])); w.w = pk2(v1[2] * sigmoidf_(v1[2]), v1[3] * sigmoidf_(v1[3]));
                            *(u32x4*)(base + (size_t)r * 512 + cb + bj * 128) = w;
                        }
                    }
            } else if (kind == 3) {
#pragma unroll
                for (int ai = 0; ai < 2; ++ai)
#pragma unroll
                    for (int m = 0; m < 4; ++m) {
                        const int r = row0 + ai * 128 + m * 16;
#pragma unroll
                        for (int bj = 0; bj < 2; ++bj) {
                            const pg8::f32x4 v0 = acc[ai][bj][m][0], v1 = acc[ai][bj][m][1];
                            u32x4 w; w.x = pk2(v0[0], v0[1]); w.y = pk2(v0[2], v0[3]); w.z = pk2(v1[0], v1[1]); w.w = pk2(v1[2], v1[3]);
                            *(u32x4*)(base + (size_t)r * 512 + cb + bj * 128) = w;
                        }
                    }
            } else {
                const float sc = kind == 1 ? QSCALE : kind == 5 ? 0.125f : 1.0f;
                const int i0 = (w0 & 63) >> 1;
                f32x4 cN = *(const f32x4*)(cosT + (row0 % LP) * 32 + i0), sN = *(const f32x4*)(sinT + (row0 % LP) * 32 + i0);
#pragma unroll
                for (int g8 = 0; g8 < 8; ++g8) {
                    const int ai = g8 >> 2, m = g8 & 3;
                    const int r = row0 + ai * 128 + m * 16;
                    const f32x4 c4 = cN * sc, s4 = sN * sc;
                    if (g8 < 7) { const int rn = row0 + ((g8 + 1) >> 2) * 128 + ((g8 + 1) & 3) * 16; const int tn = rn % LP; cN = *(const f32x4*)(cosT + tn * 32 + i0); sN = *(const f32x4*)(sinT + tn * 32 + i0); }
#pragma unroll
                    for (int bj = 0; bj < 2; ++bj) {
                        const pg8::f32x4 v0 = acc[ai][bj][m][0], v1 = acc[ai][bj][m][1];
                        u32x4 w;
                        w.x = pk2(v0[0] * c4[0] - v0[1] * s4[0], v0[1] * c4[0] + v0[0] * s4[0]);
                        w.y = pk2(v0[2] * c4[1] - v0[3] * s4[1], v0[3] * c4[1] + v0[2] * s4[1]);
                        w.z = pk2(v1[0] * c4[2] - v1[1] * s4[2], v1[1] * c4[2] + v1[0] * s4[2]);
                        w.w = pk2(v1[2] * c4[3] - v1[3] * s4[3], v1[3] * c4[3] + v1[2] * s4[3]);
                        *(u32x4*)(base + (size_t)r * 512 + cb + bj * 128) = w;
                    }
                }
            }
        }
    }
};

struct EpiOut {
    static constexpr bool PERM = false, AFTER_DRAIN = false;
    const float* src_main; const float* src_meta; int src_meta_bstride; float* dst_main; float* dst_meta;
    const float* stat; const float* pg; const float* pb;
    float* dump;
    __device__ __forceinline__ void rowp(int r, const float*& sp, float*& dp) const {
        const int b = r / LP, t = r - b * LP;
        if (t < NMETA) { sp = src_meta + (size_t)b * src_meta_bstride + t * 1024; dp = dst_meta + (size_t)(b * NMETA + t) * 1024; }
        else { const int tt = t < LV ? t : NMETA; const size_t o = ((size_t)b * SEQ + (tt - NMETA)) * 1024; sp = src_main + o; dp = (t < LV) ? (dst_main + o) : dump; }
    }
    __device__ __forceinline__ void operator()(const pg8::f32x4 (&acc)[2][2][4][2], const pg8::Unit& u, int wr, int wc, int fr, int fq) const {
        const int col0 = u.pn * 256 + wc * 32 + 4 * fq;
        const int row0 = u.pm * 256 + wr * 64 + fr;
        const bool rebuild = stat != nullptr;
        f32x4 g4[2][2], b4[2][2];
#pragma unroll
        for (int bj = 0; bj < 2; ++bj)
#pragma unroll
            for (int n = 0; n < 2; ++n) { g4[bj][n] = (f32x4){1.f, 1.f, 1.f, 1.f}; b4[bj][n] = (f32x4){0.f, 0.f, 0.f, 0.f};
                if (rebuild) { g4[bj][n] = *(const f32x4*)(pg + col0 + bj * 128 + n * 16); b4[bj][n] = *(const f32x4*)(pb + col0 + bj * 128 + n * 16); } }
        const float* spn; float* dpn; rowp(row0, spn, dpn);
        f32x4 hvn[2][2]; f32x2 stn = {0.f, 1.f};
#pragma unroll
        for (int bj = 0; bj < 2; ++bj)
#pragma unroll
            for (int n = 0; n < 2; ++n) hvn[bj][n] = *(const f32x4*)(spn + col0 + bj * 128 + n * 16);
        if (rebuild) stn = *(const f32x2*)(stat + (size_t)row0 * 2);
#pragma unroll
        for (int g8 = 0; g8 < 8; ++g8) {
            const int ai = g8 >> 2, m = g8 & 3;
            f32x4 hv[2][2]; const f32x2 st = stn; float* dp = dpn;
#pragma unroll
            for (int bj = 0; bj < 2; ++bj)
#pragma unroll
                for (int n = 0; n < 2; ++n) hv[bj][n] = hvn[bj][n];
            if (g8 < 7) {
                const int rn = row0 + ((g8 + 1) >> 2) * 128 + ((g8 + 1) & 3) * 16; rowp(rn, spn, dpn);
#pragma unroll
                for (int bj = 0; bj < 2; ++bj)
#pragma unroll
                    for (int n = 0; n < 2; ++n) hvn[bj][n] = *(const f32x4*)(spn + col0 + bj * 128 + n * 16);
                if (rebuild) stn = *(const f32x2*)(stat + (size_t)rn * 2);
            }
#pragma unroll
            for (int bj = 0; bj < 2; ++bj)
#pragma unroll
                for (int n = 0; n < 2; ++n) {
                    f32x4 h = hv[bj][n];
                    if (rebuild) h = (h - st[0]) * st[1] * g4[bj][n] + b4[bj][n];
                    *(f32x4*)(dp + col0 + bj * 128 + n * 16) = h * DN_ALPHA + acc[ai][bj][m][n];
                }
        }
    }
};

template <bool MAPPED>
__device__ __forceinline__ void p0_transpose_item(const float* W, int N, bf16_t* WT, LAS float* scr, int kb, int nb, int lane) {
    const int k0 = 64 * kb, n0 = 32 * nb;
    const int col = MAPPED ? in_colmap(n0 + (lane & 31)) : (n0 + (lane & 31));
    float wreg[32];
#pragma unroll
    for (int i = 0; i < 32; ++i) { const int kk = 2 * i + (lane >> 5); wreg[i] = (col >= 0) ? W[(size_t)(k0 + kk) * N + col] : 0.f; }
#pragma unroll
    for (int i = 0; i < 32; ++i) { const int kk = 2 * i + (lane >> 5); scr[kk * 33 + (lane & 31)] = wreg[i]; }
    asm volatile("s_waitcnt lgkmcnt(0)" ::: "memory");
    const int c = lane & 7;
#pragma unroll
    for (int j = 0; j < 4; ++j) { const int n = (lane >> 3) + 8 * j; const LAS float* s = scr + (8 * c) * 33 + n;
        u32x4 o; o.x = pk2(s[0 * 33], s[1 * 33]); o.y = pk2(s[2 * 33], s[3 * 33]); o.z = pk2(s[4 * 33], s[5 * 33]); o.w = pk2(s[6 * 33], s[7 * 33]);
        *(u32x4*)(WT + (size_t)(n0 + n) * 1024 + k0 + 8 * c) = o; }
    asm volatile("s_waitcnt lgkmcnt(0)" ::: "memory");
}

__device__ __forceinline__ void p0_prologue(const Params& p, LAS unsigned char* lds, int wave, int lane) {
    unsigned char* ws = p.ws;
    LAS float* scr = (LAS float*)(lds + wave * 8704);
    const int gw = blockIdx.x * 8 + wave, NGW = gridDim.x * 8;
    constexpr int IT_IN = 16 * (NPAD / 32), IT_OUT = 16 * 32, IT_L = IT_IN + IT_OUT;
    for (int it = gw; it < DEPTH * IT_L; it += NGW) {
        const int l = it / IT_L; int r = it - l * IT_L;
        if (r < IT_IN) { const int kb = r / (NPAD / 32), nb = r - kb * (NPAD / 32);
            p0_transpose_item<true>(p.w_in + (size_t)l * 1024 * DIN, DIN, (bf16_t*)(ws + WS_WIN) + (size_t)l * NPAD * 1024, scr, kb, nb, lane); }
        else { r -= IT_IN; const int kb = r / 32, nb = r - kb * 32;
            p0_transpose_item<false>(p.w_out + (size_t)l * 1024 * 1024, 1024, (bf16_t*)(ws + WS_WOUT) + (size_t)l * 1024 * 1024, scr, kb, nb, lane); }
    }
    bf16_t* HB = (bf16_t*)(ws + WS_HB);
    for (int r0 = gw; r0 < NR; r0 += 4 * NGW) {
        f32x4 va[4][4]; bool live[4]; int rr[4];
#pragma unroll
        for (int k = 0; k < 4; ++k) {
            const int r = r0 + k * NGW; rr[k] = r; live[k] = false;
            const int rc = r < NR ? r : r0; const int b = rc / LP, t = rc - b * LP;
            const float* src = (t < NMETA) ? (p.meta + (size_t)t * 1024) : (p.x + ((size_t)b * SEQ + ((t < LV ? t : NMETA) - NMETA)) * 1024);
            live[k] = (r < NR) && (t < LV);
#pragma unroll
            for (int j = 0; j < 4; ++j) va[k][j] = *((const f32x4*)src + lane + 64 * j);
        }
#pragma unroll
        for (int k = 0; k < 4; ++k) {
            if (rr[k] < NR) {
                u32x2* o = (u32x2*)(HB + (size_t)rr[k] * 1024) + lane;
#pragma unroll
                for (int j = 0; j < 4; ++j) { u32x2 w; w.x = live[k] ? pk2(va[k][j][0], va[k][j][1]) : 0u; w.y = live[k] ? pk2(va[k][j][2], va[k][j][3]) : 0u; o[64 * j] = w; }
            }
        }
    }
    float* cosT = (float*)(ws + WS_COS); float* sinT = (float*)(ws + WS_SIN);
    for (int i = blockIdx.x * 512 + threadIdx.x; i < LP * 32; i += gridDim.x * 512) {
        const int t = i >> 5, f = i & 31;
        const float inv_freq = powf(10000.0f, -(float)(2 * f) / 64.0f);
        const float ang = (float)t * inv_freq;
        const double rev = (double)ang * 0.15915494309189535;
        const float fr = (float)(rev - floor(rev));
        cosT[i] = __builtin_amdgcn_cosf(fr); sinT[i] = __builtin_amdgcn_sinf(fr);
    }
}

#ifndef REP_SCORE
#define REP_SCORE 1
#endif
#ifndef REP_SEL
#define REP_SEL 1
#endif
constexpr int P2_HIST = 8 * SSTR * 4, P2_RS = P2_HIST + 8 * 512 * 4, P2_CAND = P2_RS + 64, P2_CIDX = P2_CAND + 8 * 64 * 4, P2_END = P2_CIDX + 8 * 64 * 4;
static_assert(P2_END <= LDS_BYTES, "P2 LDS map");
__device__ __forceinline__ int score_bin(float sc, float rs) { const float f = __builtin_amdgcn_fmed3f(__builtin_fmaf(sc, rs, 256.0f), 0.f, 511.f); return (int)f; }
__device__ __forceinline__ unsigned ord_key(float f) { const unsigned u = __float_as_uint(f); return (u & 0x80000000u) ? ~u : (u | 0x80000000u); }

__device__ __forceinline__ void select_bisect(const LAS float* Sr, unsigned long long* brow, int nj, int lane) {
    unsigned key[66];
#pragma unroll
    for (int j = 0; j < 66; ++j) { key[j] = 0u; if (j < nj) key[j] = ord_key(Sr[64 * j + lane]); }
    unsigned prefix = 0u; bool exact = false;
    for (int bit = 31; bit >= 0; --bit) {
        const unsigned cand = prefix | (1u << bit);
        int cnt = 0;
#pragma unroll
        for (int gq = 0; gq < 5; ++gq) if (gq * 16 < nj) {
#pragma unroll
            for (int jj = 0; jj < 16; ++jj) { const int j = gq * 16 + jj; if (j < 66) cnt += __popcll(__ballot(key[j] >= cand)); }
        }
        if (cnt >= 256) { prefix = cand; if (cnt == 256) { exact = true; break; } }
    }
    const unsigned thr = prefix;
    int need = 1 << 30;
    if (!exact) { int cgt = 0;
#pragma unroll
        for (int j = 0; j < 66; ++j) if (j < nj) cgt += __popcll(__ballot(key[j] > thr));
        need = 256 - cgt; }
    int eqb = 0;
#pragma unroll
    for (int j = 0; j < 66; ++j) if (j < nj) {
        const bool gt = key[j] > thr, eq = key[j] == thr;
        const unsigned long long em = __ballot(eq);
        const int rank = eqb + (int)__builtin_amdgcn_mbcnt_hi((unsigned)(em >> 32), __builtin_amdgcn_mbcnt_lo((unsigned)em, 0u));
        const bool sel = gt || (eq && rank < need);
        const unsigned long long sm = __ballot(sel);
        if (lane == 0) brow[j] = sm;
        eqb += __popcll(em);
    }
}

__device__ __forceinline__ void idx_item(int b, int g, const bf16_t* QI, const bf16_t* KI, const float* WI, unsigned* BITS, LAS unsigned char* lds, int tid, int wave, int lane) {
    LAS float* S = (LAS float*)lds; LAS unsigned* HIST = (LAS unsigned*)(lds + P2_HIST); LAS float* RS = (LAS float*)(lds + P2_RS);
    LAS unsigned* CAND = (LAS unsigned*)(lds + P2_CAND); LAS unsigned* CIDX = (LAS unsigned*)(lds + P2_CIDX);
    const int t0 = 8 * g; const int nj = t0 / 64 + 1; const int NT32 = 2 * nj;
    const int m = lane & 31, hh = lane >> 5;
#pragma unroll
    for (int i = 0; i < 8; ++i) HIST[tid + 512 * i] = 0u;
    if (tid < 8) { const float* wp = WI + (size_t)(b * LP + t0 + tid) * 8; const f32x4 lo = *(const f32x4*)wp, hi = *(const f32x4*)(wp + 4);
        const float ss = (lo[0] * lo[0] + lo[1] * lo[1]) + (lo[2] * lo[2] + lo[3] * lo[3]) + (hi[0] * hi[0] + hi[1] * hi[1]) + (hi[2] * hi[2] + hi[3] * hi[3]);
        RS[tid] = 32.0f / sqrtf(0.5f * ss + 1e-20f); }
    {
        const int aq = 2 * ((m >> 2) & 1) + (m >> 4), ah = 4 * ((m >> 3) & 1) + (m & 3);
        bf16x8 af[2][4];
#pragma unroll
        for (int mb = 0; mb < 2; ++mb)
#pragma unroll
            for (int ks = 0; ks < 4; ++ks) af[mb][ks] = *(const bf16x8*)(QI + (size_t)(b * LP + t0 + 4 * mb + aq) * 512 + ah * 64 + ks * 16 + hh * 8);
        float wv[2][2][8];
#pragma unroll
        for (int mb = 0; mb < 2; ++mb)
#pragma unroll
            for (int qq = 0; qq < 2; ++qq) { const size_t row = (size_t)(b * LP + t0 + 4 * mb + 2 * hh + qq);
                const f32x4 lo = *(const f32x4*)(WI + row * 8), hi = *(const f32x4*)(WI + row * 8 + 4);
                wv[mb][qq][0] = lo[0]; wv[mb][qq][1] = lo[1]; wv[mb][qq][2] = lo[2]; wv[mb][qq][3] = lo[3];
                wv[mb][qq][4] = hi[0]; wv[mb][qq][5] = hi[1]; wv[mb][qq][6] = hi[2]; wv[mb][qq][7] = hi[3]; }
        const bf16_t* kbase = KI + (size_t)(b * LP + m) * 64 + hh * 8;
#define IDX_LOADB(dst, tile) do { _Pragma("unroll") for (int ks = 0; ks < 4; ++ks) dst[ks] = *(const bf16x8*)(kbase + (size_t)(32 * (tile)) * 64 + ks * 16); } while (0)
        bf16x8 kb0[4], kb1[4], kb2[4];
        for (int rsc_ = 0; rsc_ < REP_SCORE; ++rsc_) {
        const bool dh = (rsc_ == REP_SCORE - 1);
        int tl = wave;
        if (tl < NT32) IDX_LOADB(kb0, tl);
        if (tl + 8 < NT32) IDX_LOADB(kb1, tl + 8);
        if (tl + 16 < NT32) IDX_LOADB(kb2, tl + 16);
        __syncthreads();
        float rsv[2][2];
#pragma unroll
        for (int mb = 0; mb < 2; ++mb)
#pragma unroll
            for (int qq = 0; qq < 2; ++qq) rsv[mb][qq] = RS[4 * mb + 2 * hh + qq];
#define IDX_TILE(kb, tile) do { \
            const int s = 32 * (tile) + m; \
            f32x16 c0 = {}, c1 = {}; \
            _Pragma("unroll") for (int ks = 0; ks < 4; ++ks) { c0 = __builtin_amdgcn_mfma_f32_32x32x16_bf16(af[0][ks], kb[ks], c0, 0, 0, 0); c1 = __builtin_amdgcn_mfma_f32_32x32x16_bf16(af[1][ks], kb[ks], c1, 0, 0, 0); } \
            if ((tile) + 24 < NT32) IDX_LOADB(kb, (tile) + 24); \
            _Pragma("unroll") for (int qq = 0; qq < 2; ++qq) { \
                float s0 = 0.f, s1 = 0.f;     \
                _Pragma("unroll") for (int h = 0; h < 8; ++h) { s0 = fmaf(wv[0][qq][h], __builtin_amdgcn_fmed3f(c0[8 * qq + h], 0.f, 3.0e38f), s0); s1 = fmaf(wv[1][qq][h], __builtin_amdgcn_fmed3f(c1[8 * qq + h], 0.f, 3.0e38f), s1); } \
                const int q0 = 2 * hh + qq, q1 = 4 + 2 * hh + qq; \
                if (s <= t0 + q0) { if (dh) __hip_atomic_fetch_add(HIST + q0 * 512 + score_bin(s0, rsv[0][qq]), 1u, __ATOMIC_RELAXED, __HIP_MEMORY_SCOPE_WORKGROUP); } else s0 = -INFINITY; \
                if (s <= t0 + q1) { if (dh) __hip_atomic_fetch_add(HIST + q1 * 512 + score_bin(s1, rsv[1][qq]), 1u, __ATOMIC_RELAXED, __HIP_MEMORY_SCOPE_WORKGROUP); } else s1 = -INFINITY; \
                S[q0 * SSTR + s] = s0; S[q1 * SSTR + s] = s1; \
            } } while (0)
        for (; tl < NT32; tl += 24) {
            IDX_TILE(kb0, tl);
            if (tl + 8 < NT32) IDX_TILE(kb1, tl + 8);
            if (tl + 16 < NT32) IDX_TILE(kb2, tl + 16);
        }
        }
#undef IDX_TILE
#undef IDX_LOADB
    }
    __syncthreads();
    for (int rse_ = 0; rse_ < REP_SEL; ++rse_) {
        const int t = t0 + wave;
        const LAS float* Sr = S + wave * SSTR;
        unsigned long long* brow = (unsigned long long*)(BITS + (size_t)(b * LP + t) * BW);
        if (t < 256) {
            for (int j = 0; j < nj; ++j) { const unsigned long long mk = __ballot((64 * j + lane) <= t); if (lane == 0) brow[j] = mk; }
        } else {
            const LAS unsigned* H = HIST + wave * 512;
            const u32x4 ha = *(const LAS u32x4*)(H + 8 * lane), hb = *(const LAS u32x4*)(H + 8 * lane + 4);
            const unsigned lsum = (ha.x + ha.y) + (ha.z + ha.w) + (hb.x + hb.y) + (hb.z + hb.w);
            unsigned incl = lsum;
#pragma unroll
            for (int o = 1; o < 64; o <<= 1) { const unsigned v = __shfl_down(incl, o); if (lane + o < 64) incl += v; }
            unsigned cum = incl - lsum; int Bsel = -1; unsigned cab = 0u;
#define P2_STEP(hv, i) do { if (Bsel < 0 && cum < 256u && cum + (hv) >= 256u) { Bsel = 8 * lane + (i); cab = cum; } cum += (hv); } while (0)
            P2_STEP(hb.w, 7); P2_STEP(hb.z, 6); P2_STEP(hb.y, 5); P2_STEP(hb.x, 4); P2_STEP(ha.w, 3); P2_STEP(ha.z, 2); P2_STEP(ha.y, 1); P2_STEP(ha.x, 0);
#undef P2_STEP
            const unsigned long long fm = __ballot(Bsel >= 0);
            const int src = (int)__ffsll((unsigned long long)fm) - 1;
            const int Bb = __builtin_amdgcn_readlane(Bsel, src);
            const int c_above = __builtin_amdgcn_readlane((int)cab, src);
            const int cB = (int)H[Bb];
            const int rr = 256 - c_above;
            if (fm == 0ull || cB > 64 || rr < 1 || rr > cB) {
                select_bisect(Sr, brow, nj, lane);
            } else {
                const float rs = RS[wave];
                const float hiT = (Bb >= 511) ? INFINITY : (float)(Bb + 1), loT = (Bb <= 0) ? -INFINITY : (float)Bb;
                const int jt = t >> 6; const unsigned long long tailm = (~0ull) >> (63 - (t & 63));
                unsigned long long w0 = 0ull, w1 = 0ull;
                int cnt = 0;
#define SEL_CHUNK(fv, j, vm) do { \
                        const float vv = __builtin_fmaf((fv), rs, 256.0f); \
                        const unsigned long long mh = __ballot(vv >= hiT) & (vm); \
                        const unsigned long long mc = __ballot(vv >= loT) & (vm) & ~mh; \
                        if (lane == ((j) & 63)) { if ((j) < 64) w0 = mh; else w1 = mh; } \
                        if (mc != 0ull) { \
                            const bool is = (mc >> lane) & 1ull; \
                            const int pos = cnt + (int)__builtin_amdgcn_mbcnt_hi((unsigned)(mc >> 32), __builtin_amdgcn_mbcnt_lo((unsigned)mc, 0u)); \
                            if (is && pos < 64) { CAND[wave * 64 + pos] = ord_key(fv); CIDX[wave * 64 + pos] = (unsigned)(64 * (j) + lane); } \
                            cnt += __popcll(mc); \
                        } } while (0)
                int j0 = 0;
                for (; j0 + 4 <= jt; j0 += 4) {
                    float f4[4];
#pragma unroll
                    for (int i = 0; i < 4; ++i) f4[i] = Sr[64 * (j0 + i) + lane];
#pragma unroll
                    for (int i = 0; i < 4; ++i) SEL_CHUNK(f4[i], j0 + i, ~0ull);
                }
                for (; j0 <= jt; ++j0) {
                    const float f1 = Sr[64 * j0 + lane];
                    const unsigned long long vm = (j0 < jt) ? ~0ull : tailm;
                    SEL_CHUNK(f1, j0, vm);
                }
#undef SEL_CHUNK
                asm volatile("s_waitcnt lgkmcnt(0)" ::: "memory");
                const unsigned myk = (lane < cB) ? CAND[wave * 64 + lane] : 0u;
                const unsigned myi = (lane < cB) ? CIDX[wave * 64 + lane] : 0u;
                int rank = 0;
                for (int jj = 0; jj < cB; ++jj) { const unsigned kj = (unsigned)__builtin_amdgcn_readlane((int)myk, jj); rank += ((kj > myk) || (kj == myk && jj < lane)) ? 1 : 0; }
                unsigned long long chosen = __ballot(lane < cB && rank < rr);
                while (chosen != 0ull) {
                    const int c = (int)__ffsll((unsigned long long)chosen) - 1; chosen &= chosen - 1ull;
                    const unsigned ci = (unsigned)__builtin_amdgcn_readlane((int)myi, c);
                    const int jc = (int)(ci >> 6); const unsigned long long bit = 1ull << (ci & 63u);
                    if (lane == (jc & 63)) { if (jc < 64) w0 |= bit; else w1 |= bit; }
                }
                if (lane < nj) brow[lane] = w0;
                if (lane < 2 && 64 + lane < nj) brow[64 + lane] = w1;
            }
        }
    }
    __syncthreads();
}

__device__ __forceinline__ void conv_tile(int b, int ti, const bf16_t* U, const bf16_t* ZC, const float* cw, const float* cb, const float* lg, const float* lb,
                                          bf16_t* YMIX, LAS float* C, int tid, int wave, int lane) {
    const int t0 = 32 * ti;
    {
        const int cp = tid & 255, rh = tid >> 8;
        float w0[31], w1[31];
#pragma unroll
        for (int j = 0; j < 31; ++j) { const f32x2 ww = *(const f32x2*)(cw + j * 512 + 2 * cp); w0[j] = ww[0]; w1[j] = ww[1]; }
        const f32x2 bias = *(const f32x2*)(cb + 2 * cp);
        float x0[46], x1[46];
#pragma unroll
        for (int i = 0; i < 46; ++i) { const int t = t0 - 30 + 16 * rh + i; x0[i] = 0.f; x1[i] = 0.f;
            if (t >= 0) { const unsigned pu = *(const unsigned*)(U + (size_t)(b * LP + t) * 512 + 2 * cp); x0[i] = bflo(pu); x1[i] = bfhi(pu); } }
#pragma unroll
        for (int o = 0; o < 16; ++o) { float a0 = bias[0], a1 = bias[1];
#pragma unroll
            for (int j = 0; j < 31; ++j) { a0 = fmaf(w0[j], x0[o + j], a0); a1 = fmaf(w1[j], x1[o + j], a1); }
            f32x2 r2; r2[0] = a0; r2[1] = a1; *(LAS f32x2*)(C + (16 * rh + o) * 512 + 2 * cp) = r2; }
    }
    const f32x4 g0 = *(const f32x4*)(lg + lane * 8), g1 = *(const f32x4*)(lg + lane * 8 + 4), b0 = *(const f32x4*)(lb + lane * 8), b1 = *(const f32x4*)(lb + lane * 8 + 4);
    u32x4 zz[4];
#pragma unroll
    for (int rr = 0; rr < 4; ++rr) zz[rr] = *(const u32x4*)(ZC + (size_t)(b * LP + t0 + 4 * wave + rr) * 512 + lane * 8);
    asm volatile("s_waitcnt lgkmcnt(0)\n\ts_barrier" ::: "memory");
    {
        f32x4 a0[4], a1[4]; float sm[4], sq[4];
#pragma unroll
        for (int rr = 0; rr < 4; ++rr) { const LAS float* cr = C + (4 * wave + rr) * 512 + lane * 8; a0[rr] = *(const LAS f32x4*)cr; a1[rr] = *(const LAS f32x4*)(cr + 4);
            sm[rr] = (a0[rr][0] + a0[rr][1]) + (a0[rr][2] + a0[rr][3]) + (a1[rr][0] + a1[rr][1]) + (a1[rr][2] + a1[rr][3]); }
#pragma unroll
        for (int o = 1; o < 64; o <<= 1) {
#pragma unroll
            for (int rr = 0; rr < 4; ++rr) sm[rr] += __shfl_xor(sm[rr], o); }
#pragma unroll
        for (int rr = 0; rr < 4; ++rr) { const float mean = sm[rr] * (1.f / 512.f); a0[rr] = a0[rr] - mean; a1[rr] = a1[rr] - mean;
            sq[rr] = (a0[rr][0] * a0[rr][0] + a0[rr][1] * a0[rr][1]) + (a0[rr][2] * a0[rr][2] + a0[rr][3] * a0[rr][3]) + (a1[rr][0] * a1[rr][0] + a1[rr][1] * a1[rr][1]) + (a1[rr][2] * a1[rr][2] + a1[rr][3] * a1[rr][3]); }
#pragma unroll
        for (int o = 1; o < 64; o <<= 1) {
#pragma unroll
            for (int rr = 0; rr < 4; ++rr) sq[rr] += __shfl_xor(sq[rr], o); }
#pragma unroll
        for (int rr = 0; rr < 4; ++rr) {
            const float rstd = 1.0f / sqrtf(sq[rr] * (1.f / 512.f) + LN_EPS);
            const size_t row = (size_t)(b * LP + t0 + 4 * wave + rr);
            const u32x4 z = zz[rr];
            const f32x4 y0 = a0[rr] * rstd * g0 + b0, y1 = a1[rr] * rstd * g1 + b1;
            u32x4 w;
            w.x = pk2(y0[0] * sigmoidf_(y0[0]) * bflo(z.x), y0[1] * sigmoidf_(y0[1]) * bfhi(z.x));
            w.y = pk2(y0[2] * sigmoidf_(y0[2]) * bflo(z.y), y0[3] * sigmoidf_(y0[3]) * bfhi(z.y));
            w.z = pk2(y1[0] * sigmoidf_(y1[0]) * bflo(z.z), y1[1] * sigmoidf_(y1[1]) * bfhi(z.z));
            w.w = pk2(y1[2] * sigmoidf_(y1[2]) * bflo(z.w), y1[3] * sigmoidf_(y1[3]) * bfhi(z.w));
            *(u32x4*)(YMIX + row * 1024 + lane * 8) = w;
        }
    }
    asm volatile("s_waitcnt lgkmcnt(0)\n\ts_barrier" ::: "memory");
}

constexpr int KSTR = 272, VSTR = 320;
typedef short v4i16_t __attribute__((ext_vector_type(4)));
__device__ __forceinline__ float vmax3(float a, float b, float c) { float r; asm("v_max3_f32 %0, %1, %2, %3" : "=v"(r) : "v"(a), "v"(b), "v"(c)); return r; }
#define bfe1(w, c) ({ unsigned m_; asm("v_bfe_i32 %0, %1, %2, 1" : "=v"(m_) : "v"(w), "n"(c)); m_; })
__device__ __forceinline__ void attn_unit(int b, int hp, int qb, const bf16_t* Q, const bf16_t* K, const bf16_t* V, const bf16_t* ZA, const unsigned* BITS, bf16_t* YMIX,
                                          LAS unsigned char* lds, int tid, int wave, int lane) {
    const int hl = wave >> 2, h = 2 * hp + hl;
    const int q0 = 128 * qb, qw0 = q0 + 32 * (wave & 3);
    const int n = lane & 31, hh = lane >> 5;
    const size_t qrow = (size_t)(b * LP + qw0 + n);
    bf16x8 qf[4];
#pragma unroll
    for (int ks = 0; ks < 4; ++ks) qf[ks] = *(const bf16x8*)(Q + qrow * 512 + h * 64 + ks * 16 + hh * 8);
    const int NT = 2 * qb + 2;
    LAS unsigned char* Ks = lds; LAS unsigned char* Vs = lds + 2 * 64 * KSTR;
    const int r0 = tid >> 4, ch = tid & 15;
    const size_t gb = (size_t)(b * LP) * 512 + hp * 128 + ch * 8;
    u32x4 kA0, kA1, vA0, vA1, kB0, kB1, vB0, vB1;
#define ATT_LOAD(tile, k0, k1, v0, v1) do { const size_t ro = gb + (size_t)(64 * (tile) + r0) * 512; k0 = *(const u32x4*)(K + ro); k1 = *(const u32x4*)(K + ro + 32 * 512); v0 = *(const u32x4*)(V + ro); v1 = *(const u32x4*)(V + ro + 32 * 512); } while (0)
#define ATT_STORE(buf, k0, k1, v0, v1) do { *(LAS u32x4*)(Ks + (buf) * 64 * KSTR + r0 * KSTR + ch * 16) = k0; *(LAS u32x4*)(Ks + (buf) * 64 * KSTR + (r0 + 32) * KSTR + ch * 16) = k1; \
        *(LAS u32x4*)(Vs + (buf) * 64 * VSTR + r0 * VSTR + ch * 16) = v0; *(LAS u32x4*)(Vs + (buf) * 64 * VSTR + (r0 + 32) * VSTR + ch * 16) = v1; } while (0)
#define ATT_BAR() asm volatile("s_waitcnt lgkmcnt(0)\n\ts_barrier" ::: "memory")
    const unsigned long long* mrow = (const unsigned long long*)(BITS + qrow * BW);
    ATT_LOAD(0, kA0, kA1, vA0, vA1); ATT_LOAD(1, kB0, kB1, vB0, vB1);
    ATT_STORE(0, kA0, kA1, vA0, vA1);
    if (NT > 2) ATT_LOAD(2, kA0, kA1, vA0, vA1);
    unsigned long long mwA = mrow[0], mwB = mrow[1];
    ATT_BAR();
    float mrun = 0.f, lrun = 0.f; f32x16 o0 = {}, o1 = {}, negm = {};
    const int qq4 = (lane & 15) >> 2, pp = lane & 3, blk = (lane >> 4) & 1;
    for (int tile2 = 0; tile2 < NT; tile2 += 2) {
#pragma unroll
        for (int half = 0; half < 2; ++half) {
            const int tile = tile2 + half; const int buf = half;
            const unsigned long long mw = half ? mwB : mwA;
            if (64 * tile <= qw0 + 31 && qw0 < LV) {
            f32x16 s0 = negm, s1 = negm;
            const LAS unsigned char* kb = Ks + buf * 64 * KSTR + n * KSTR + hl * 128 + hh * 16;
            bf16x8 kf0[4], kf1[4];
#pragma unroll
            for (int ks = 0; ks < 4; ++ks) { kf0[ks] = *(const LAS bf16x8*)(kb + ks * 32); kf1[ks] = *(const LAS bf16x8*)(kb + 32 * KSTR + ks * 32); }
            __builtin_amdgcn_sched_barrier(0);
#pragma unroll
            for (int ks = 0; ks < 4; ++ks) {
                s0 = __builtin_amdgcn_mfma_f32_32x32x16_bf16(kf0[ks], qf[ks], s0, 0, 0, 0);
                s1 = __builtin_amdgcn_mfma_f32_32x32x16_bf16(kf1[ks], qf[ks], s1, 0, 0, 0);
            }
            const LAS unsigned char* vb = Vs + buf * 64 * VSTR + (4 * hh + qq4) * VSTR + (hl * 64 + 16 * blk + 4 * pp) * 2;
            s16x4 vlo[2][2][2], vhi[2][2][2];
#pragma unroll
            for (int mb = 0; mb < 2; ++mb)
#pragma unroll
                for (int ks = 0; ks < 2; ++ks)
#pragma unroll
                    for (int db = 0; db < 2; ++db) {
                        const LAS unsigned char* vk = vb + (32 * mb + 16 * ks) * VSTR;
                        vlo[mb][ks][db] = __builtin_bit_cast(s16x4, __builtin_amdgcn_ds_read_tr16_b64_v4i16((LAS v4i16_t*)(vk + db * 64)));
                        vhi[mb][ks][db] = __builtin_bit_cast(s16x4, __builtin_amdgcn_ds_read_tr16_b64_v4i16((LAS v4i16_t*)(vk + 8 * VSTR + db * 64)));
                    }
            __builtin_amdgcn_sched_barrier(0);
            float mxa = fmaxf(s0[0], s1[0]), mxb = fmaxf(s0[1], s1[1]);
#pragma unroll
            for (int r = 2; r < 16; r += 2) { mxa = vmax3(mxa, s0[r], s1[r]); mxb = vmax3(mxb, s0[r + 1], s1[r + 1]); }
            float mx = fmaxf(mxa, mxb);
            if (__any(mx > 6.0f)) {
                mx = fmaxf(mx, __shfl_xor(mx, 32));
                const float dl = fmaxf(mx, 0.f);
                mrun += dl;
                const float alpha = __builtin_amdgcn_exp2f(-dl);
                lrun *= alpha;
#pragma unroll
                for (int r = 0; r < 16; ++r) { s0[r] -= dl; s1[r] -= dl; o0[r] *= alpha; o1[r] *= alpha; negm[r] = -mrun; }
            }
            const int wl = (int)((unsigned)mw >> (4 * hh)), wh = (int)((unsigned)(mw >> 32) >> (4 * hh));
            f32x2 ps2 = {0.f, 0.f};
#pragma unroll
            for (int r = 0; r < 16; r += 2) {
                const int c0b = (r & 3) + 8 * (r >> 2), c1b = ((r + 1) & 3) + 8 * ((r + 1) >> 2);
                const float a0 = __uint_as_float(__float_as_uint(__builtin_amdgcn_exp2f(s0[r])) & bfe1(wl, c0b));
                const float a1 = __uint_as_float(__float_as_uint(__builtin_amdgcn_exp2f(s0[r + 1])) & bfe1(wl, c1b));
                const float b0 = __uint_as_float(__float_as_uint(__builtin_amdgcn_exp2f(s1[r])) & bfe1(wh, c0b));
                const float b1 = __uint_as_float(__float_as_uint(__builtin_amdgcn_exp2f(s1[r + 1])) & bfe1(wh, c1b));
                s0[r] = a0; s0[r + 1] = a1; s1[r] = b0; s1[r + 1] = b1;
                ps2 += (f32x2){a0, a1}; ps2 += (f32x2){b0, b1};
            }
            lrun += ps2[0] + ps2[1];
            __builtin_amdgcn_sched_barrier(0);
#pragma unroll
            for (int mb = 0; mb < 2; ++mb)
#pragma unroll
                for (int ks = 0; ks < 2; ++ks) {
                    bf16x8 pf;
                    { u32x4 pw;
                      if (mb == 0) { pw.x = pk2(s0[8 * ks + 0], s0[8 * ks + 1]); pw.y = pk2(s0[8 * ks + 2], s0[8 * ks + 3]); pw.z = pk2(s0[8 * ks + 4], s0[8 * ks + 5]); pw.w = pk2(s0[8 * ks + 6], s0[8 * ks + 7]); }
                      else         { pw.x = pk2(s1[8 * ks + 0], s1[8 * ks + 1]); pw.y = pk2(s1[8 * ks + 2], s1[8 * ks + 3]); pw.z = pk2(s1[8 * ks + 4], s1[8 * ks + 5]); pw.w = pk2(s1[8 * ks + 6], s1[8 * ks + 7]); }
                      pf = __builtin_bit_cast(bf16x8, pw); }
#pragma unroll
                    for (int db = 0; db < 2; ++db) {
                        const s16x4 lo = vlo[mb][ks][db], hi = vhi[mb][ks][db];
                        const bf16x8 vf = (bf16x8){lo[0], lo[1], lo[2], lo[3], hi[0], hi[1], hi[2], hi[3]};
                        if (db == 0) o0 = __builtin_amdgcn_mfma_f32_32x32x16_bf16(vf, pf, o0, 0, 0, 0);
                        else         o1 = __builtin_amdgcn_mfma_f32_32x32x16_bf16(vf, pf, o1, 0, 0, 0);
                    }
                }
            }
            if (half == 0) {
                ATT_STORE(1, kB0, kB1, vB0, vB1);
                if (tile + 3 < NT) ATT_LOAD(tile + 3, kB0, kB1, vB0, vB1);
                if (tile + 2 < NT) mwA = mrow[tile + 2];
            } else {
                if (tile + 1 < NT) { ATT_STORE(0, kA0, kA1, vA0, vA1); if (tile + 3 < NT) ATT_LOAD(tile + 3, kA0, kA1, vA0, vA1); }
                if (tile + 2 < NT) mwB = mrow[tile + 2];
            }
            ATT_BAR();
        }
    }
#undef ATT_LOAD
#undef ATT_STORE
#undef ATT_BAR
    lrun += __shfl_xor(lrun, 32);
    const float inv = 1.0f / lrun;
#pragma unroll
    for (int db = 0; db < 2; ++db)
#pragma unroll
        for (int g4 = 0; g4 < 4; ++g4) {
            const int d0 = 32 * db + 8 * g4 + 4 * hh;
            const u32x2 z = *(const u32x2*)(ZA + qrow * 512 + h * 64 + d0);
            float v0, v1, v2, v3;
            if (db == 0) { v0 = o0[4 * g4]; v1 = o0[4 * g4 + 1]; v2 = o0[4 * g4 + 2]; v3 = o0[4 * g4 + 3]; } else { v0 = o1[4 * g4]; v1 = o1[4 * g4 + 1]; v2 = o1[4 * g4 + 2]; v3 = o1[4 * g4 + 3]; }
            u32x2 w; w.x = pk2(v0 * inv * bflo(z.x), v1 * inv * bfhi(z.x)); w.y = pk2(v2 * inv * bflo(z.y), v3 * inv * bfhi(z.y));
            *(u32x2*)(YMIX + qrow * 1024 + 512 + h * 64 + d0) = w;
        }
}

__device__ __forceinline__ void ln_phase(const Params& p, int l, int wave, int lane) {
    const int gw = blockIdx.x * 8 + wave, NGW = gridDim.x * 8;
    bf16_t* HB = (bf16_t*)(p.ws + WS_HB); float* METAH = (float*)(p.ws + WS_METAH);
    const float* G = p.post_g + l * 1024; const float* Bv = p.post_b + l * 1024;
    f32x4 gg[4], bb[4];
#pragma unroll
    for (int j = 0; j < 4; ++j) { gg[j] = *((const f32x4*)G + lane + 64 * j); bb[j] = *((const f32x4*)Bv + lane + 64 * j); }
    constexpr int NGRP = NB * LV / 4;
    for (int g = gw; g < NGRP; g += NGW) {
        const int v0 = 4 * g; const int b = v0 / LV, t0 = v0 - b * LV;
        float* hp[4]; f32x4 v[4][4]; float s[4], q[4];
#pragma unroll
        for (int i = 0; i < 4; ++i) { const int t = t0 + i; hp[i] = (t < NMETA) ? (METAH + (size_t)(b * NMETA + t) * 1024) : (p.out + ((size_t)b * SEQ + (t - NMETA)) * 1024); }
#pragma unroll
        for (int i = 0; i < 4; ++i) { s[i] = 0.f;
#pragma unroll
            for (int j = 0; j < 4; ++j) { v[i][j] = *((const f32x4*)hp[i] + lane + 64 * j); } }
#pragma unroll
        for (int i = 0; i < 4; ++i)
#pragma unroll
            for (int j = 0; j < 4; ++j) s[i] += (v[i][j][0] + v[i][j][1]) + (v[i][j][2] + v[i][j][3]);
#pragma unroll
        for (int o = 1; o < 64; o <<= 1) {
#pragma unroll
            for (int i = 0; i < 4; ++i) s[i] += __shfl_xor(s[i], o); }
#pragma unroll
        for (int i = 0; i < 4; ++i) { const float mean = s[i] * (1.f / 1024.f); s[i] = mean; q[i] = 0.f;
#pragma unroll
            for (int j = 0; j < 4; ++j) { v[i][j] = v[i][j] - mean; q[i] += (v[i][j][0] * v[i][j][0] + v[i][j][1] * v[i][j][1]) + (v[i][j][2] * v[i][j][2] + v[i][j][3] * v[i][j][3]); } }
#pragma unroll
        for (int o = 1; o < 64; o <<= 1) {
#pragma unroll
            for (int i = 0; i < 4; ++i) q[i] += __shfl_xor(q[i], o); }
#pragma unroll
        for (int i = 0; i < 4; ++i) {
            const float rstd = 1.0f / sqrtf(q[i] * (1.f / 1024.f) + LN_EPS);
            const size_t r = (size_t)(b * LP + t0 + i);
            u32x2* o = (u32x2*)(HB + r * 1024) + lane;
            if (lane == 0 && l < DEPTH - 1) { f32x2 st; st[0] = s[i]; st[1] = rstd; *(f32x2*)((float*)(p.ws + WS_STAT) + r * 2) = st; }
#pragma unroll
            for (int j = 0; j < 4; ++j) { const f32x4 y = v[i][j] * rstd * gg[j] + bb[j]; if (l == DEPTH - 1) *((f32x4*)hp[i] + lane + 64 * j) = y;
                if (l < DEPTH - 1) { u32x2 w; w.x = pk2(y[0], y[1]); w.y = pk2(y[2], y[3]); o[64 * j] = w; } }
        }
    }
}

#define XB_TMO      128
#define XB_XCNT(j)  (256  + 64 * (j))
#define XB_XSUB(j)  (1280 + 64 * (j))
#define XB_XGEN(j)  (2304 + 64 * (j))
#define XB_TOP      3328
#define XB_TOPGEN   3392
#define XCD_BAR_WORDS 3456
#define XB_SPIN_CAP (1u << 18)

__device__ __forceinline__ unsigned xb_ld(unsigned* p)              { return __hip_atomic_load(p, __ATOMIC_RELAXED, __HIP_MEMORY_SCOPE_AGENT); }
__device__ __forceinline__ unsigned xb_add(unsigned* p, unsigned v) { return __hip_atomic_fetch_add(p, v, __ATOMIC_RELAXED, __HIP_MEMORY_SCOPE_AGENT); }
__device__ __forceinline__ unsigned xb_xcc_id() { return (unsigned)__builtin_amdgcn_s_getreg((3 << 11) | 20) & 0xFu; }
#define XB_SPIN(cond, bar) do { unsigned _sp = 0; while (cond) { __builtin_amdgcn_s_sleep(1); \
    if ((++_sp & 255u) == 0u) { if (xb_ld(&(bar)[XB_TMO])) break; if (_sp > XB_SPIN_CAP) { atomicAdd(&(bar)[XB_TMO], 1u); break; } } } } while (0)

struct XcdBarrier {
    unsigned* bar; unsigned x;
    volatile LAS unsigned* st;
};

__device__ __forceinline__ XcdBarrier xcd_barrier_post(unsigned* bar, volatile LAS unsigned* st) {
    XcdBarrier b; b.bar = bar; b.x = xb_xcc_id(); b.st = st;
    if (threadIdx.x == 0) (void)xb_add(&bar[XB_XCNT(b.x)], 1u);
    return b;
}
__device__ __forceinline__ void xcd_barrier_complete(unsigned* bar, unsigned x, unsigned& nloc, unsigned& nx) {
    const unsigned G = gridDim.x * gridDim.y * gridDim.z;
    unsigned sum, cnt, mine, sp = 0u;
    for (;;) {
        sum = 0u; cnt = 0u; mine = 0u;
#pragma unroll
        for (unsigned j = 0; j < 16; ++j) { const unsigned c = xb_ld(&bar[XB_XCNT(j)]); sum += c; cnt += (c > 0u) ? 1u : 0u; mine = (j == x) ? c : mine; }
        if (sum == G) break;
        __builtin_amdgcn_s_sleep(1);
        if ((++sp & 255u) == 0u) { if (xb_ld(&bar[XB_TMO])) break; if (sp > XB_SPIN_CAP) { atomicAdd(&bar[XB_TMO], 1u); break; } }
    }
    nloc = mine > 0u ? mine : 1u; nx = cnt > 0u ? cnt : 1u;
}

__device__ __forceinline__ void xcd_barrier(const XcdBarrier& b) {
    asm volatile("s_waitcnt vmcnt(0)" ::: "memory");
    __syncthreads();
    if (threadIdx.x == 0) {
        unsigned* bar = b.bar;
        __builtin_amdgcn_s_waitcnt(0);
        unsigned nloc = b.st[0], nx = b.st[1];
        if (nloc == 0u) { xcd_barrier_complete(bar, b.x, nloc, nx); b.st[0] = nloc; b.st[1] = nx; }
        const unsigned old = xb_add(&bar[XB_XSUB(b.x)], 1u);
        const unsigned gen = old / nloc;
        if (old + 1u == (gen + 1u) * nloc) {
            __builtin_amdgcn_fence(__ATOMIC_RELEASE, "agent");
            asm volatile("s_waitcnt vmcnt(0)" ::: "memory");
            const unsigned og = xb_add(&bar[XB_TOP], 1u);
            const unsigned tg = og / nx;
            if (og + 1u == (tg + 1u) * nx) xb_add(&bar[XB_TOPGEN], 1u);
            else XB_SPIN(xb_ld(&bar[XB_TOPGEN]) == tg, bar);
            __builtin_amdgcn_fence(__ATOMIC_ACQUIRE, "agent");
            xb_add(&bar[XB_XGEN(b.x)], 1u);
            asm volatile("s_waitcnt vmcnt(0)" ::: "memory");
        } else {
            XB_SPIN(xb_ld(&bar[XB_XGEN(b.x)]) == gen, bar);
            __builtin_amdgcn_fence(__ATOMIC_ACQUIRE, "agent");
            asm volatile("s_waitcnt vmcnt(0)" ::: "memory");
        }
    }
    __syncthreads();
}

#ifndef REP_P2
#define REP_P2 1
#endif
#ifndef REP_IDX
#define REP_IDX 1
#endif
#ifndef REP_CONV
#define REP_CONV 1
#endif
#ifndef REP_P0
#define REP_P0 1
#endif
#ifndef REP_SYNC
#define REP_SYNC 0
#endif
#ifndef REP_P3
#define REP_P3 1
#endif
#ifndef REP_G1
#define REP_G1 1
#endif
__global__ void __launch_bounds__(512, 2) fwd_megakernel(Params p) {
    extern __shared__ __attribute__((aligned(16))) unsigned char lds_raw[];
    cg::grid_group grid = cg::this_grid();
    LAS unsigned char* lds = (LAS unsigned char*)lds_raw;
    const int tid = threadIdx.x, lane = tid & 63, wave = __builtin_amdgcn_readfirstlane(tid >> 6);
    const int G = gridDim.x, bx = blockIdx.x;
    unsigned char* ws = p.ws;
    bf16_t* HB = (bf16_t*)(ws + WS_HB);
    bf16_t *U = (bf16_t*)(ws + WS_U), *ZC = (bf16_t*)(ws + WS_ZC), *Q = (bf16_t*)(ws + WS_Q), *K = (bf16_t*)(ws + WS_K), *V = (bf16_t*)(ws + WS_V),
           *ZA = (bf16_t*)(ws + WS_ZA), *QI = (bf16_t*)(ws + WS_QI), *KI = (bf16_t*)(ws + WS_KI), *YMIX = (bf16_t*)(ws + WS_YMIX);
    float* WI = (float*)(ws + WS_WI); unsigned* BITS = (unsigned*)(ws + WS_BITS); float* METAH = (float*)(ws + WS_METAH);
    const float* cosT = (const float*)(ws + WS_COS); const float* sinT = (const float*)(ws + WS_SIN);

    if (tid < 16) ((LAS unsigned*)(lds + LDS_BYTES - 64))[tid] = 0u;
    __syncthreads();
    const XcdBarrier xbar = xcd_barrier_post((unsigned*)(ws + WS_BAR), (volatile LAS unsigned*)(lds + LDS_BYTES - 64));
#define GSYNC() xcd_barrier(xbar)
    if (p.ws == nullptr) grid.sync();
#ifndef NO_P0
    for (int rp_ = 0; rp_ < REP_P0; ++rp_) p0_prologue(p, lds, wave, lane);
#endif
    GSYNC();
    for (int rs_ = 0; rs_ < REP_SYNC; ++rs_) GSYNC();

#define LAUNDER() int tid_ = tid, wave_ = wave; asm volatile("" : "+v"(tid_)); asm volatile("" : "+s"(wave_)); const int lane_ = tid_ & 63; (void)lane_; (void)wave_
#pragma unroll 1
    for (int l = 0; l < DEPTH; ++l) {
#ifndef NO_G1
        for (int rep_ = 0; rep_ < REP_G1; ++rep_) {
            pg8::Gemm g{HB, (const bf16_t*)(ws + WS_WIN) + (size_t)l * NPAD * 1024, NR, NPAD, 1024};
            pg8::StaticOrder S; S.init(NR, NPAD, G, bx);
            EpiIn E{U, ZC, Q, K, V, ZA, QI, KI, WI, cosT, sinT};
            pg8::gemm_phase<EpiIn, pg8::StaticOrder, true, true>(lds, g, S, E);
        }
#endif
        GSYNC();
#ifndef NO_P2
        for (int rep_ = 0; rep_ < REP_P2; ++rep_) {
            LAUNDER();
            constexpr int NITEM = NB * (LV / 8);
            for (int ri_ = 0; ri_ < REP_IDX; ++ri_)
            for (int k = 0; k * G < NITEM; ++k) {
                const int idx = (k & 1) ? (k * G + (G - 1 - bx)) : (k * G + bx);
                if (idx < NITEM) { const int g = (LV / 8 - 1) - idx / NB, b = idx % NB; idx_item(b, g, QI, KI, WI, BITS, lds, tid_, wave_, lane_); }
            }
            constexpr int NCT = NB * (LP / 32);
            for (int rc_ = 0; rc_ < REP_CONV; ++rc_)
            for (int ct = (G - 1 - bx); ct < NCT; ct += G) {
                const int b = ct / (LP / 32), ti = ct - b * (LP / 32);
                if (32 * ti >= LV) continue;
                conv_tile(b, ti, U, ZC, p.conv_w + (size_t)l * 31 * 512, p.conv_b + l * 512, p.conv_ln_g + l * 512, p.conv_ln_b + l * 512, YMIX, (LAS float*)lds, tid_, wave_, lane_);
            }
        }
#endif
        GSYNC();
#ifndef NO_P3
        for (int rep_ = 0; rep_ < REP_P3; ++rep_) {
            LAUNDER();
            constexpr int NU = NB * 4 * (LP / 128);
            for (int k = 0; k * G < NU; ++k) {
                const int idx = (k & 1) ? (k * G + (G - 1 - bx)) : (k * G + bx);
                if (idx < NU) { const int qb = (LP / 128 - 1) - idx / 32, bh = idx % 32; attn_unit(bh >> 2, bh & 3, qb, Q, K, V, ZA, BITS, YMIX, lds, tid_, wave_, lane_); }
            }
        }
#endif
        GSYNC();
#ifndef NO_G2
        {
            pg8::Gemm g{YMIX, (const bf16_t*)(ws + WS_WOUT) + (size_t)l * 1024 * 1024, NR, 1024, 1024};
            pg8::StaticOrder S; S.init(NR, 1024, G, bx);
            EpiOut E{l == 0 ? p.x : p.out, l == 0 ? p.meta : METAH, l == 0 ? 0 : NMETA * 1024, p.out, METAH,
                     l == 0 ? (const float*)nullptr : (const float*)(ws + WS_STAT), p.post_g + (l > 0 ? l - 1 : 0) * 1024, p.post_b + (l > 0 ? l - 1 : 0) * 1024, (float*)(ws + WS_DUMP)};
            pg8::gemm_phase<EpiOut, pg8::StaticOrder, true, true>(lds, g, S, E);
        }
#endif
        GSYNC();
#ifndef NO_P4
        { LAUNDER(); ln_phase(p, l, wave_, lane_); }
#endif
        if (l < DEPTH - 1) GSYNC();
    }
}

extern "C" void kernel_launch(void* const* d_in, const int* in_sizes, int n_in, void* d_out, int out_size, void* d_ws, size_t ws_size, hipStream_t stream) {
    static int grid_blocks = 0;
    if (grid_blocks == 0) {
        if (ws_size < WS_END) { fprintf(stderr, "kernel_launch: workspace too small: %zu < %zu\n", ws_size, (size_t)WS_END); grid_blocks = -1; return; }
        int dev = 0, cus = 0, per_cu = 0;
        hipGetDevice(&dev);
        hipDeviceGetAttribute(&cus, hipDeviceAttributeMultiprocessorCount, dev);
        if (hipFuncSetAttribute((const void*)fwd_megakernel, hipFuncAttributeMaxDynamicSharedMemorySize, LDS_BYTES) != hipSuccess) { fprintf(stderr, "kernel_launch: hipFuncSetAttribute failed\n"); }
        if (hipOccupancyMaxActiveBlocksPerMultiprocessor(&per_cu, (const void*)fwd_megakernel, 512, LDS_BYTES) != hipSuccess || per_cu < 1) { fprintf(stderr, "kernel_launch: occupancy query gave %d\n", per_cu); per_cu = 1; }
        (void)hipGetLastError();
        if (per_cu > 1) per_cu = 1;
        grid_blocks = cus * per_cu;
    }
    if (grid_blocks < 0) return;
    Params p{};
    p.x = (const float*)d_in[0]; p.meta = (const float*)d_in[1]; p.w_in = (const float*)d_in[2]; p.conv_w = (const float*)d_in[3]; p.conv_b = (const float*)d_in[4];
    p.conv_ln_g = (const float*)d_in[5]; p.conv_ln_b = (const float*)d_in[6]; p.w_out = (const float*)d_in[7]; p.post_g = (const float*)d_in[8]; p.post_b = (const float*)d_in[9];
    p.out = (float*)d_out; p.ws = (unsigned char*)d_ws;
    void* args[] = {&p};
    if (hipMemsetAsync((char*)d_ws + WS_BAR, 0, 16384, stream) != hipSuccess) { fprintf(stderr, "kernel_launch: hipMemsetAsync of the barrier words failed\n"); return; }
    hipError_t e = hipLaunchCooperativeKernel((const void*)fwd_megakernel, dim3(grid_blocks), dim3(512), args, LDS_BYTES, stream);
    if (e != hipSuccess) fprintf(stderr, "cooperative launch failed: %s (grid %d)\n", hipGetErrorString(e), grid_blocks);
}
```

```cpp
#include <hip/hip_runtime.h>
#include <hip/hip_cooperative_groups.h>
#include <cstdio>
#include <cstdint>
namespace cg = cooperative_groups;
namespace pg8 {
#define PG8_LAS __attribute__((address_space(3)))
typedef unsigned short bf16_t;
typedef short bf16x8 __attribute__((ext_vector_type(8)));
typedef float f32x4 __attribute__((ext_vector_type(4)));
typedef unsigned u32x4 __attribute__((ext_vector_type(4)));
constexpr int BM = 256, BK = 64, HALF = 128, HTB = HALF * BK * 2  , STAGE_BYTES = 8 * HTB, NXCD = 8, WGM = 8;

__host__ __device__ __forceinline__ int lds_byte(int r, int c) { const int st = (r >> 4) * 2 + (c >> 5), rr = r & 15, cc = c & 31, ob = rr * 64 + cc * 2; return st * 1024 + (ob ^ (((ob >> 9) & 1) << 5)); }
__host__ __device__ __forceinline__ void stage_rc(int b, int& R, int& C) { const int st = b / 1024, sb = b % 1024, swz = sb ^ (((sb >> 9) & 1) << 5); R = (st >> 1) * 16 + swz / 64; C = (st & 1) * 32 + (swz % 64) / 2; }
__host__ __device__ __forceinline__ int perm32(int rho) { const int n = rho >> 4, i = rho & 15; return 8 * (i >> 2) + 4 * n + (i & 3); }

struct Unit { int pm, pn; };
struct Gemm { const bf16_t* A; const bf16_t* Bt; int M, N, K; };

struct StaticOrder {
    int nM, nN, nwg, G, c;
    __host__ __device__ void init(int M, int N, int G_, int c_) { nM = M / BM; nN = N / BM; nwg = nM * nN; G = G_; c = c_; }
    __host__ __device__ bool next(int i, Unit& u) const {
        const long L = (long)i * G + c; if (L >= nwg) return false;
        int wgid = (int)L; { const int q = nwg / NXCD, r = nwg % NXCD, xcd = wgid % NXCD, off = wgid / NXCD; wgid = (xcd < r ? xcd * (q + 1) : r * (q + 1) + (xcd - r) * q) + off; }
        const int nig = WGM * nN, gid = wgid / nig, fm = gid * WGM, gsz = (nM - fm) < WGM ? (nM - fm) : WGM;
        u.pm = fm + ((wgid % nig) % gsz); u.pn = (wgid % nig) / gsz; return true;
    }
    __device__ __forceinline__ void a_ready(const Unit&) const {}
    __device__ __forceinline__ void done(const Unit&) const {}
};
template <class Epi, class Sched, bool ALIGN_EPI = false, bool SP2 = false>
__device__ __forceinline__ void gemm_phase(PG8_LAS unsigned char* lds, const Gemm g, const Sched& S, const Epi& E) {
    int tid = threadIdx.x; asm volatile("" : "+v"(tid)); const int wid = __builtin_amdgcn_readfirstlane(tid >> 6), lane = tid & 63, wr = wid >> 2, wc = wid & 3, fr = lane & 15, fq = lane >> 4;
    const int K = g.K, nt = K / BK;
    unsigned voffA[2], voffB[2];
#pragma unroll
    for (int i = 0; i < 2; ++i) { int R, C; stage_rc(tid * 16 + i * 8192, R, C); const int Rb = Epi::PERM ? ((R & ~31) + perm32(R & 31)) : R;
        voffA[i] = (unsigned)(R * K + C) * 2u; voffB[i] = (unsigned)(Rb * K + C) * 2u; }
    const size_t kstep = (size_t)(BK * 2);
    const size_t hstep = (size_t)HALF * K * 2;
    const size_t tstep = 2 * hstep;
    const unsigned ldsw = (unsigned)wid * 1024u;
    const int aoff = lds_byte(wr * 64 + fr, fq * 8), boff = lds_byte(wc * 32 + fr, fq * 8);
#define PG8_SA(b, h) (((b) * 2 + (h)) * HTB)
#define PG8_SB(b, h) ((4 + (b) * 2 + (h)) * HTB)
#define PG8_STAGE(bufoff, gbase, voff) do { _Pragma("unroll") for (int _i = 0; _i < 2; ++_i) \
        __builtin_amdgcn_global_load_lds((const unsigned*)((const char*)(gbase) + (voff)[_i]), (PG8_LAS unsigned*)(lds + (bufoff) + ldsw + _i * 8192), 16, 0, 0); } while (0)
#define PG8_LDA(dst, b, h) do { _Pragma("unroll") for (int m = 0; m < 4; ++m) _Pragma("unroll") for (int k = 0; k < 2; ++k) dst[m][k] = *(const PG8_LAS bf16x8*)(lds + PG8_SA(b, h) + aoff + m * 2048 + k * 1024); } while (0)
#define PG8_LDB(dst, b, h) do { _Pragma("unroll") for (int n = 0; n < 2; ++n) _Pragma("unroll") for (int k = 0; k < 2; ++k) dst[n][k] = *(const PG8_LAS bf16x8*)(lds + PG8_SB(b, h) + boff + n * 2048 + k * 1024); } while (0)
#define PG8_MMA(ai, bj, At, Bt) do { __builtin_amdgcn_s_setprio(1); _Pragma("unroll") for (int m = 0; m < 4; ++m) _Pragma("unroll") for (int n = 0; n < 2; ++n) _Pragma("unroll") for (int k = 0; k < 2; ++k) \
        acc[ai][bj][m][n] = __builtin_amdgcn_mfma_f32_16x16x32_bf16(Bt[n][k], At[m][k], acc[ai][bj][m][n], 0, 0, 0); __builtin_amdgcn_s_setprio(0); } while (0)
#define PG8_WAIT_V(n) asm volatile("s_waitcnt vmcnt(" #n ")" ::: "memory")
#define PG8_WAIT_L(n) asm volatile("s_waitcnt lgkmcnt(" #n ")" ::: "memory")
#define PG8_BAR __builtin_amdgcn_s_barrier()
#define PG8_SCHED __builtin_amdgcn_sched_barrier(0)
    Unit cur, nxt; int ui = 0;
    if (!S.next(0, cur)) return;
    f32x4 acc[2][2][4][2];
#pragma unroll
    for (int a = 0; a < 2; ++a)
#pragma unroll
        for (int b = 0; b < 2; ++b)
#pragma unroll
            for (int m = 0; m < 4; ++m)
#pragma unroll
                for (int n = 0; n < 2; ++n) acc[a][b][m][n] = (f32x4){0.f, 0.f, 0.f, 0.f};
    bf16x8 At[4][2], B0[2][2], B1[2][2];
    const char* cA = (const char*)g.A + (size_t)cur.pm * tstep; const char* cB = (const char*)g.Bt + (size_t)cur.pn * tstep;
    S.a_ready(cur);
    if constexpr (SP2) {
        PG8_STAGE(PG8_SB(0, 0), cB, voffB); PG8_STAGE(PG8_SB(0, 1), cB + hstep, voffB); PG8_STAGE(PG8_SA(0, 0), cA, voffA); PG8_STAGE(PG8_SA(0, 1), cA + hstep, voffA);
        if (wr == 1) PG8_BAR;
        PG8_WAIT_V(2); PG8_BAR;
        PG8_STAGE(PG8_SB(1, 0), cB + kstep, voffB); PG8_STAGE(PG8_SA(1, 0), cA + kstep, voffA); PG8_STAGE(PG8_SB(1, 1), cB + hstep + kstep, voffB);
        PG8_WAIT_V(6); PG8_BAR;
    } else {
        PG8_STAGE(PG8_SB(0, 0), cB, voffB); PG8_STAGE(PG8_SA(0, 0), cA, voffA); PG8_STAGE(PG8_SB(0, 1), cB + hstep, voffB); PG8_STAGE(PG8_SA(0, 1), cA + hstep, voffA);
        if (wr == 1) PG8_BAR;
        PG8_WAIT_V(4); PG8_BAR;
        PG8_STAGE(PG8_SB(1, 0), cB + kstep, voffB); PG8_STAGE(PG8_SA(1, 0), cA + kstep, voffA); PG8_STAGE(PG8_SB(1, 1), cB + hstep + kstep, voffB);
        PG8_WAIT_V(6); PG8_BAR;
    }
    for (;;) {
        const bool has_next = S.next(ui + 1, nxt);
        const char* nA = has_next ? (const char*)g.A + (size_t)nxt.pm * tstep : cA; const char* nB = has_next ? (const char*)g.Bt + (size_t)nxt.pn * tstep : cB;
        for (int t = 0; t < nt; t += 2) {
            const bool last = (t == nt - 2);
            const char* a1 = cA + (size_t)(t + 1) * kstep;
            const char* a2 = last ? nA : cA + (size_t)(t + 2) * kstep; const char* b2 = last ? nB : cB + (size_t)(t + 2) * kstep;
            const char* a3 = a2 + kstep; const char* b3 = b2 + kstep;
            if (last && has_next) S.a_ready(nxt);
            if constexpr (SP2) {
            PG8_LDB(B0, 0, 0); PG8_LDB(B1, 0, 1); PG8_SCHED; PG8_LDA(At, 0, 0); PG8_STAGE(PG8_SA(1, 1), a1 + hstep, voffA);
            PG8_WAIT_V(8); PG8_WAIT_L(0); PG8_BAR; PG8_MMA(0, 0, At, B0); PG8_MMA(0, 1, At, B1); PG8_BAR; PG8_SCHED;
            PG8_LDA(At, 0, 1); PG8_STAGE(PG8_SB(0, 0), b2, voffB); PG8_STAGE(PG8_SB(0, 1), b2 + hstep, voffB); PG8_STAGE(PG8_SA(0, 0), a2, voffA);
            PG8_WAIT_V(8); PG8_WAIT_L(0); PG8_BAR; PG8_MMA(1, 0, At, B0); PG8_MMA(1, 1, At, B1); PG8_BAR; PG8_SCHED;
            PG8_LDB(B0, 1, 0); PG8_LDB(B1, 1, 1); PG8_SCHED; PG8_LDA(At, 1, 0); PG8_STAGE(PG8_SA(0, 1), a2 + hstep, voffA);
            PG8_WAIT_V(8); PG8_WAIT_L(0); PG8_BAR; PG8_MMA(0, 0, At, B0); PG8_MMA(0, 1, At, B1); PG8_BAR; PG8_SCHED;
            PG8_LDA(At, 1, 1); PG8_STAGE(PG8_SB(1, 0), b3, voffB); PG8_STAGE(PG8_SB(1, 1), b3 + hstep, voffB); PG8_STAGE(PG8_SA(1, 0), a3, voffA);
            PG8_WAIT_V(8); PG8_WAIT_L(0); PG8_BAR; PG8_MMA(1, 0, At, B0); PG8_MMA(1, 1, At, B1); PG8_BAR; PG8_SCHED;
            } else {
            PG8_LDB(B0, 0, 0); PG8_SCHED; PG8_LDA(At, 0, 0); PG8_STAGE(PG8_SA(1, 1), a1 + hstep, voffA);
            PG8_WAIT_L(8); PG8_BAR; PG8_WAIT_L(0); PG8_MMA(0, 0, At, B0); PG8_BAR; PG8_SCHED;
            PG8_LDB(B1, 0, 1); PG8_STAGE(PG8_SB(0, 0), b2, voffB);
            PG8_BAR; PG8_WAIT_L(0); PG8_MMA(0, 1, At, B1); PG8_BAR;
            PG8_LDA(At, 0, 1); PG8_STAGE(PG8_SA(0, 0), a2, voffA);
            PG8_BAR; PG8_WAIT_L(0); PG8_MMA(1, 0, At, B0); PG8_BAR; PG8_SCHED;
            PG8_STAGE(PG8_SB(0, 1), b2 + hstep, voffB);
            PG8_WAIT_V(6); PG8_BAR; PG8_MMA(1, 1, At, B1); PG8_BAR;
            PG8_LDB(B0, 1, 0); PG8_SCHED; PG8_LDA(At, 1, 0); PG8_STAGE(PG8_SA(0, 1), a2 + hstep, voffA);
            PG8_WAIT_L(8); PG8_BAR; PG8_WAIT_L(0); PG8_MMA(0, 0, At, B0); PG8_BAR; PG8_SCHED;
            PG8_LDB(B1, 1, 1); PG8_STAGE(PG8_SB(1, 0), b3, voffB);
            PG8_BAR; PG8_WAIT_L(0); PG8_MMA(0, 1, At, B1); PG8_BAR;
            PG8_LDA(At, 1, 1); PG8_STAGE(PG8_SA(1, 0), a3, voffA);
            PG8_BAR; PG8_WAIT_L(0); PG8_MMA(1, 0, At, B0); PG8_BAR; PG8_SCHED;
            PG8_STAGE(PG8_SB(1, 1), b3 + hstep, voffB);
            PG8_WAIT_V(6); PG8_BAR; PG8_MMA(1, 1, At, B1); PG8_BAR;
            }
        }
        if constexpr (ALIGN_EPI) { if (wr == 0) PG8_BAR; }
        if constexpr (!Epi::AFTER_DRAIN) { E(acc, cur, wr, wc, fr, fq); S.done(cur); }
        if (!has_next) break;
#pragma unroll
        for (int a = 0; a < 2; ++a)
#pragma unroll
            for (int b = 0; b < 2; ++b)
#pragma unroll
                for (int m = 0; m < 4; ++m)
#pragma unroll
                    for (int n = 0; n < 2; ++n) acc[a][b][m][n] = (f32x4){0.f, 0.f, 0.f, 0.f};
        cur = nxt; cA = nA; cB = nB; ++ui;
        if constexpr (ALIGN_EPI) { if (wr == 1) PG8_BAR; }
    }
    PG8_WAIT_V(0);
    if constexpr (!ALIGN_EPI) { if (wr == 0) PG8_BAR; }
    PG8_BAR;
    if constexpr (Epi::AFTER_DRAIN) { E.fused(acc, cur, wr, wc, fr, fq, lds, wid, lane); S.done(cur); }
#undef PG8_SA
#undef PG8_SB
#undef PG8_STAGE
#undef PG8_LDA
#undef PG8_LDB
#undef PG8_MMA
#undef PG8_WAIT_V
#undef PG8_WAIT_L
#undef PG8_BAR
#undef PG8_SCHED
}
}

#define LAS __attribute__((address_space(3)))
typedef unsigned short bf16_t;
typedef short bf16x8 __attribute__((ext_vector_type(8)));
typedef short s16x4 __attribute__((ext_vector_type(4)));
typedef float f32x4 __attribute__((ext_vector_type(4)));
typedef float f32x2 __attribute__((ext_vector_type(2)));
typedef float f32x16 __attribute__((ext_vector_type(16)));
typedef unsigned u32x4 __attribute__((ext_vector_type(4)));
typedef unsigned u32x2 __attribute__((ext_vector_type(2)));
typedef __bf16 bf16x2_t __attribute__((ext_vector_type(2)));

constexpr int NB = 8, SEQ = 4096, DM = 1024, DEPTH = 4, NMETA = 16;
constexpr int LV = SEQ + NMETA;
constexpr int LP = 4224;
constexpr int NR = NB * LP;
constexpr int DIN = 4168, NPAD = 4352;
constexpr int BW = 132;
constexpr float LN_EPS = 1e-5f;
constexpr float DN_ALPHA = 1.681792830507429f;
constexpr float QSCALE = 0.125f * 1.4426950408889634f;
constexpr float IDX_W_SCALE = 0.35355339059327373f;
constexpr int SSTR = 4232;
constexpr int LDS_BYTES = 157696;

constexpr size_t al256(size_t x) { return (x + 255) & ~(size_t)255; }
constexpr size_t WS_BAR = 0;
constexpr size_t WS_COS = 16384;
constexpr size_t WS_SIN = WS_COS + al256((size_t)LP * 32 * 4);
constexpr size_t WS_WIN = WS_SIN + al256((size_t)LP * 32 * 4);
constexpr size_t WS_WOUT = WS_WIN + (size_t)DEPTH * NPAD * 1024 * 2;
constexpr size_t WS_HB = WS_WOUT + (size_t)DEPTH * 1024 * 1024 * 2;
constexpr size_t SZ512 = (size_t)NR * 512 * 2;
constexpr size_t WS_U = WS_HB + (size_t)NR * 1024 * 2;
constexpr size_t WS_ZC = WS_U + SZ512;
constexpr size_t WS_Q = WS_ZC + SZ512;
constexpr size_t WS_K = WS_Q + SZ512;
constexpr size_t WS_V = WS_K + SZ512;
constexpr size_t WS_ZA = WS_V + SZ512;
constexpr size_t WS_QI = WS_ZA + SZ512;
constexpr size_t WS_KI = WS_QI + SZ512;
constexpr size_t WS_WI = WS_KI + (size_t)NR * 64 * 2;
constexpr size_t WS_YMIX = WS_WI + (size_t)NR * 8 * 4;
constexpr size_t WS_BITS = WS_YMIX + (size_t)NR * 1024 * 2;
constexpr size_t WS_METAH = WS_BITS + (size_t)NR * BW * 4;
constexpr size_t WS_STAT = WS_METAH + (size_t)NB * NMETA * 1024 * 4;
constexpr size_t WS_DUMP = WS_STAT + (size_t)NR * 2 * 4;
constexpr size_t WS_END = WS_DUMP + 4096;

struct Params {
    const float* x; const float* meta; const float* w_in; const float* conv_w; const float* conv_b;
    const float* conv_ln_g; const float* conv_ln_b; const float* w_out; const float* post_g; const float* post_b;
    float* out; unsigned char* ws;
};

__device__ __forceinline__ unsigned pk2(float lo, float hi) { f32x2 v = {lo, hi}; bf16x2_t b = __builtin_convertvector(v, bf16x2_t); return __builtin_bit_cast(unsigned, b); }
__device__ __forceinline__ float bflo(unsigned w) { return __uint_as_float(w << 16); }
__device__ __forceinline__ float bfhi(unsigned w) { return __uint_as_float(w & 0xffff0000u); }
__device__ __forceinline__ float sigmoidf_(float x) { return __builtin_amdgcn_rcpf(1.0f + __expf(-x)); }
__device__ __forceinline__ float wave_sum(float v) {
#pragma unroll
    for (int o = 1; o < 64; o <<= 1) v += __shfl_xor(v, o);
    return v;
}

__device__ __forceinline__ int in_colmap(int c) {
    const int pn = c >> 8, w = c & 255;
    if (pn < 4) return (w < 128) ? (128 * pn + w) : (512 + 128 * pn + (w - 128));
    if (pn == 16) { if (w < 64) return 4096 + (w >> 1) + 32 * (w & 1); if (w < 72) return 4160 + (w - 64); return -1; }
    const int kind = (pn - 4) >> 1;
    const int base = 1024 + 512 * kind + 256 * (pn & 1);
    if (kind == 1 || kind == 2 || kind == 5) return base + 64 * (w >> 6) + ((w & 63) >> 1) + 32 * (w & 1);
    return base + w;
}

struct EpiIn {
    static constexpr bool PERM = true, AFTER_DRAIN = false;
    bf16_t *U, *ZC, *Q, *K, *V, *ZA, *QI, *KI; float* WI; const float* cosT; const float* sinT;
    __device__ __forceinline__ void operator()(const pg8::f32x4 (&acc)[2][2][4][2], const pg8::Unit& u, int wr, int wc, int fr, int fq) const {
        const int pn = u.pn;
        const int row0 = u.pm * 256 + wr * 64 + fr;
        const int w0 = wc * 32 + 8 * fq;
        if (pn < 4) {
#pragma unroll
            for (int ai = 0; ai < 2; ++ai)
#pragma unroll
                for (int m = 0; m < 4; ++m) {
                    const int r = row0 + ai * 128 + m * 16;
                    const pg8::f32x4 a0 = acc[ai][0][m][0], a1 = acc[ai][0][m][1], g0 = acc[ai][1][m][0], g1 = acc[ai][1][m][1];
                    u32x4 w;
                    w.x = pk2(a0[0] * sigmoidf_(g0[0]), a0[1] * sigmoidf_(g0[1])); w.y = pk2(a0[2] * sigmoidf_(g0[2]), a0[3] * sigmoidf_(g0[3]));
                    w.z = pk2(a1[0] * sigmoidf_(g1[0]), a1[1] * sigmoidf_(g1[1])); w.w = pk2(a1[2] * sigmoidf_(g1[2]), a1[3] * sigmoidf_(g1[3]));
                    *(u32x4*)(U + (size_t)r * 512 + pn * 128 + w0) = w;
                }
        } else if (pn == 16) {
            if (w0 < 64) {
                const int i0 = w0 >> 1;
#pragma unroll
                for (int ai = 0; ai < 2; ++ai)
#pragma unroll
                    for (int m = 0; m < 4; ++m) {
                        const int r = row0 + ai * 128 + m * 16; const int t = r % LP;
                        const f32x4 c4 = *(const f32x4*)(cosT + t * 32 + i0), s4 = *(const f32x4*)(sinT + t * 32 + i0);
                        const pg8::f32x4 v0 = acc[ai][0][m][0], v1 = acc[ai][0][m][1];
                        u32x4 w;
                        w.x = pk2(v0[0] * c4[0] - v0[1] * s4[0], v0[1] * c4[0] + v0[0] * s4[0]);
                        w.y = pk2(v0[2] * c4[1] - v0[3] * s4[1], v0[3] * c4[1] + v0[2] * s4[1]);
                        w.z = pk2(v1[0] * c4[2] - v1[1] * s4[2], v1[1] * c4[2] + v1[0] * s4[2]);
                        w.w = pk2(v1[2] * c4[3] - v1[3] * s4[3], v1[3] * c4[3] + v1[2] * s4[3]);
                        *(u32x4*)(KI + (size_t)r * 64 + w0) = w;
                    }
            } else if (w0 == 64) {
#pragma unroll
                for (int ai = 0; ai < 2; ++ai)
#pragma unroll
                    for (int m = 0; m < 4; ++m) {
                        const int r = row0 + ai * 128 + m * 16;
                        *(f32x4*)(WI + (size_t)r * 8) = acc[ai][0][m][0] * IDX_W_SCALE;
                        *(f32x4*)(WI + (size_t)r * 8 + 4) = acc[ai][0][m][1] * IDX_W_SCALE;
                    }
            }
        } else {
            const int kind = (pn - 4) >> 1;
            bf16_t* base = kind == 0 ? ZC : kind == 1 ? Q : kind == 2 ? K : kind == 3 ? V : kind == 4 ? ZA : QI;
            const int cb = (pn & 1) * 256 + w0;
            if (kind == 0 || kind == 4) {
#pragma unroll
                for (int ai = 0; ai < 2; ++ai)
#pragma unroll
                    for (int m = 0; m < 4; ++m) {
                        const int r = row0 + ai * 128 + m * 16;
#pragma unroll
                        for (int bj = 0; bj < 2; ++bj) {
                            const pg8::f32x4 v0 = acc[ai][bj][m][0], v1 = acc[ai][bj][m][1];
                            u32x4 w;
                            w.x = pk2(v0[0] * sigmoidf_(v0[0]), v0[1] * sigmoidf_(v0[1])); w.y = pk2(v0[2] * sigmoidf_(v0[2]), v0[3] * sigmoidf_(v0[3]));
                            w.z = pk2(v1[0] * sigmoidf_(v1[0]), v1[1] * sigmoidf_(v1[1])); w.w = pk2(v1[2] * sigmoidf_(v1[2]), v1[3] * sigmoidf_(v1[3]));
                            *(u32x4*)(base + (size_t)r * 512 + cb + bj * 128) = w;
                        }
                    }
            } else if (kind == 3) {
#pragma unroll
                for (int ai = 0; ai < 2; ++ai)
#pragma unroll
                    for (int m = 0; m < 4; ++m) {
                        const int r = row0 + ai * 128 + m * 16;
#pragma unroll
                        for (int bj = 0; bj < 2; ++bj) {
                            const pg8::f32x4 v0 = acc[ai][bj][m][0], v1 = acc[ai][bj][m][1];
                            u32x4 w; w.x = pk2(v0[0], v0[1]); w.y = pk2(v0[2], v0[3]); w.z = pk2(v1[0], v1[1]); w.w = pk2(v1[2], v1[3]);
                            *(u32x4*)(base + (size_t)r * 512 + cb + bj * 128) = w;
                        }
                    }
            } else {
                const float sc = kind == 1 ? QSCALE : kind == 5 ? 0.125f : 1.0f;
                const int i0 = (w0 & 63) >> 1;
                f32x4 cN = *(const f32x4*)(cosT + (row0 % LP) * 32 + i0), sN = *(const f32x4*)(sinT + (row0 % LP) * 32 + i0);
#pragma unroll
                for (int g8 = 0; g8 < 8; ++g8) {
                    const int ai = g8 >> 2, m = g8 & 3;
                    const int r = row0 + ai * 128 + m * 16;
                    const f32x4 c4 = cN * sc, s4 = sN * sc;
                    if (g8 < 7) { const int rn = row0 + ((g8 + 1) >> 2) * 128 + ((g8 + 1) & 3) * 16; const int tn = rn % LP; cN = *(const f32x4*)(cosT + tn * 32 + i0); sN = *(const f32x4*)(sinT + tn * 32 + i0); }
#pragma unroll
                    for (int bj = 0; bj < 2; ++bj) {
                        const pg8::f32x4 v0 = acc[ai][bj][m][0], v1 = acc[ai][bj][m][1];
                        u32x4 w;
                        w.x = pk2(v0[0] * c4[0] - v0[1] * s4[0], v0[1] * c4[0] + v0[0] * s4[0]);
                        w.y = pk2(v0[2] * c4[1] - v0[3] * s4[1], v0[3] * c4[1] + v0[2] * s4[1]);
                        w.z = pk2(v1[0] * c4[2] - v1[1] * s4[2], v1[1] * c4[2] + v1[0] * s4[2]);
                        w.w = pk2(v1[2] * c4[3] - v1[3] * s4[3], v1[3] * c4[3] + v1[2] * s4[3]);
                        *(u32x4*)(base + (size_t)r * 512 + cb + bj * 128) = w;
                    }
                }
            }
        }
    }
};

struct EpiOut {
    static constexpr bool PERM = false, AFTER_DRAIN = false;
    const float* src_main; const float* src_meta; int src_meta_bstride; float* dst_main; float* dst_meta;
    const float* stat; const float* pg; const float* pb;
    float* dump;
    __device__ __forceinline__ void rowp(int r, const float*& sp, float*& dp) const {
        const int b = r / LP, t = r - b * LP;
        if (t < NMETA) { sp = src_meta + (size_t)b * src_meta_bstride + t * 1024; dp = dst_meta + (size_t)(b * NMETA + t) * 1024; }
        else { const int tt = t < LV ? t : NMETA; const size_t o = ((size_t)b * SEQ + (tt - NMETA)) * 1024; sp = src_main + o; dp = (t < LV) ? (dst_main + o) : dump; }
    }
    __device__ __forceinline__ void operator()(const pg8::f32x4 (&acc)[2][2][4][2], const pg8::Unit& u, int wr, int wc, int fr, int fq) const {
        const int col0 = u.pn * 256 + wc * 32 + 4 * fq;
        const int row0 = u.pm * 256 + wr * 64 + fr;
        const bool rebuild = stat != nullptr;
        f32x4 g4[2][2], b4[2][2];
#pragma unroll
        for (int bj = 0; bj < 2; ++bj)
#pragma unroll
            for (int n = 0; n < 2; ++n) { g4[bj][n] = (f32x4){1.f, 1.f, 1.f, 1.f}; b4[bj][n] = (f32x4){0.f, 0.f, 0.f, 0.f};
                if (rebuild) { g4[bj][n] = *(const f32x4*)(pg + col0 + bj * 128 + n * 16); b4[bj][n] = *(const f32x4*)(pb + col0 + bj * 128 + n * 16); } }
        const float* spn; float* dpn; rowp(row0, spn, dpn);
        f32x4 hvn[2][2]; f32x2 stn = {0.f, 1.f};
#pragma unroll
        for (int bj = 0; bj < 2; ++bj)
#pragma unroll
            for (int n = 0; n < 2; ++n) hvn[bj][n] = *(const f32x4*)(spn + col0 + bj * 128 + n * 16);
        if (rebuild) stn = *(const f32x2*)(stat + (size_t)row0 * 2);
#pragma unroll
        for (int g8 = 0; g8 < 8; ++g8) {
            const int ai = g8 >> 2, m = g8 & 3;
            f32x4 hv[2][2]; const f32x2 st = stn; float* dp = dpn;
#pragma unroll
            for (int bj = 0; bj < 2; ++bj)
#pragma unroll
                for (int n = 0; n < 2; ++n) hv[bj][n] = hvn[bj][n];
            if (g8 < 7) {
                const int rn = row0 + ((g8 + 1) >> 2) * 128 + ((g8 + 1) & 3) * 16; rowp(rn, spn, dpn);
#pragma unroll
                for (int bj = 0; bj < 2; ++bj)
#pragma unroll
                    for (int n = 0; n < 2; ++n) hvn[bj][n] = *(const f32x4*)(spn + col0 + bj * 128 + n * 16);
                if (rebuild) stn = *(const f32x2*)(stat + (size_t)rn * 2);
            }
#pragma unroll
            for (int bj = 0; bj < 2; ++bj)
#pragma unroll
                for (int n = 0; n < 2; ++n) {
                    f32x4 h = hv[bj][n];
                    if (rebuild) h = (h - st[0]) * st[1] * g4[bj][n] + b4[bj][n];
                    *(f32x4*)(dp + col0 + bj * 128 + n * 16) = h * DN_ALPHA + acc[ai][bj][m][n];
                }
        }
    }
};

template <bool MAPPED>
__device__ __forceinline__ void p0_transpose_item(const float* W, int N, bf16_t* WT, LAS float* scr, int kb, int nb, int lane) {
    const int k0 = 64 * kb, n0 = 32 * nb;
    const int col = MAPPED ? in_colmap(n0 + (lane & 31)) : (n0 + (lane & 31));
    float wreg[32];
#pragma unroll
    for (int i = 0; i < 32; ++i) { const int kk = 2 * i + (lane >> 5); wreg[i] = (col >= 0) ? W[(size_t)(k0 + kk) * N + col] : 0.f; }
#pragma unroll
    for (int i = 0; i < 32; ++i) { const int kk = 2 * i + (lane >> 5); scr[kk * 33 + (lane & 31)] = wreg[i]; }
    asm volatile("s_waitcnt lgkmcnt(0)" ::: "memory");
    const int c = lane & 7;
#pragma unroll
    for (int j = 0; j < 4; ++j) { const int n = (lane >> 3) + 8 * j; const LAS float* s = scr + (8 * c) * 33 + n;
        u32x4 o; o.x = pk2(s[0 * 33], s[1 * 33]); o.y = pk2(s[2 * 33], s[3 * 33]); o.z = pk2(s[4 * 33], s[5 * 33]); o.w = pk2(s[6 * 33], s[7 * 33]);
        *(u32x4*)(WT + (size_t)(n0 + n) * 1024 + k0 + 8 * c) = o; }
    asm volatile("s_waitcnt lgkmcnt(0)" ::: "memory");
}

__device__ __forceinline__ void convert_layer(const Params& p, int l, LAS unsigned char* lds, int iw, int nw, int wave, int lane) {
    unsigned char* ws = p.ws;
    LAS float* scr = (LAS float*)(lds + wave * 8704);
    constexpr int IT_IN = 16 * (NPAD / 32), IT_OUT = 16 * 32, IT_L = IT_IN + IT_OUT;
    for (int it = iw; it < IT_L; it += nw) {
        int r = it;
        if (r < IT_IN) { const int kb = r / (NPAD / 32), nb = r - kb * (NPAD / 32);
            p0_transpose_item<true>(p.w_in + (size_t)l * 1024 * DIN, DIN, (bf16_t*)(ws + WS_WIN) + (size_t)l * NPAD * 1024, scr, kb, nb, lane); }
        else { r -= IT_IN; const int kb = r / 32, nb = r - kb * 32;
            p0_transpose_item<false>(p.w_out + (size_t)l * 1024 * 1024, 1024, (bf16_t*)(ws + WS_WOUT) + (size_t)l * 1024 * 1024, scr, kb, nb, lane); }
    }
}
__device__ __forceinline__ void p0_prologue(const Params& p, LAS unsigned char* lds, int wave, int lane) {
    unsigned char* ws = p.ws;
    LAS float* scr = (LAS float*)(lds + wave * 8704);
    const int gw = blockIdx.x * 8 + wave, NGW = gridDim.x * 8;
    (void)scr;
    convert_layer(p, 0, lds, gw, NGW, wave, lane);
    bf16_t* HB = (bf16_t*)(ws + WS_HB);
    for (int r0 = gw; r0 < NR; r0 += 4 * NGW) {
        f32x4 va[4][4]; bool live[4]; int rr[4];
#pragma unroll
        for (int k = 0; k < 4; ++k) {
            const int r = r0 + k * NGW; rr[k] = r; live[k] = false;
            const int rc = r < NR ? r : r0; const int b = rc / LP, t = rc - b * LP;
            const float* src = (t < NMETA) ? (p.meta + (size_t)t * 1024) : (p.x + ((size_t)b * SEQ + ((t < LV ? t : NMETA) - NMETA)) * 1024);
            live[k] = (r < NR) && (t < LV);
#pragma unroll
            for (int j = 0; j < 4; ++j) va[k][j] = *((const f32x4*)src + lane + 64 * j);
        }
#pragma unroll
        for (int k = 0; k < 4; ++k) {
            if (rr[k] < NR) {
                u32x2* o = (u32x2*)(HB + (size_t)rr[k] * 1024) + lane;
#pragma unroll
                for (int j = 0; j < 4; ++j) { u32x2 w; w.x = live[k] ? pk2(va[k][j][0], va[k][j][1]) : 0u; w.y = live[k] ? pk2(va[k][j][2], va[k][j][3]) : 0u; o[64 * j] = w; }
            }
        }
    }
    float* cosT = (float*)(ws + WS_COS); float* sinT = (float*)(ws + WS_SIN);
    for (int i = blockIdx.x * 512 + threadIdx.x; i < LP * 32; i += gridDim.x * 512) {
        const int t = i >> 5, f = i & 31;
        const float inv_freq = powf(10000.0f, -(float)(2 * f) / 64.0f);
        const float ang = (float)t * inv_freq;
        const double rev = (double)ang * 0.15915494309189535;
        const float fr = (float)(rev - floor(rev));
        cosT[i] = __builtin_amdgcn_cosf(fr); sinT[i] = __builtin_amdgcn_sinf(fr);
    }
}

#ifndef REP_SCORE
#define REP_SCORE 1
#endif
#ifndef REP_SEL
#define REP_SEL 1
#endif
constexpr int P2_HIST = 8 * SSTR * 4, P2_RS = P2_HIST + 8 * 512 * 4, P2_CAND = P2_RS + 64, P2_CIDX = P2_CAND + 8 * 64 * 4, P2_END = P2_CIDX + 8 * 64 * 4;
static_assert(P2_END <= LDS_BYTES, "P2 LDS map");
__device__ __forceinline__ int score_bin(float sc, float rs) { const float f = __builtin_amdgcn_fmed3f(__builtin_fmaf(sc, rs, 256.0f), 0.f, 511.f); return (int)f; }
__device__ __forceinline__ unsigned ord_key(float f) { const unsigned u = __float_as_uint(f); return (u & 0x80000000u) ? ~u : (u | 0x80000000u); }

__device__ __forceinline__ void select_bisect(const LAS float* Sr, unsigned long long* brow, int nj, int lane) {
    unsigned key[66];
#pragma unroll
    for (int j = 0; j < 66; ++j) { key[j] = 0u; if (j < nj) key[j] = ord_key(Sr[64 * j + lane]); }
    unsigned prefix = 0u; bool exact = false;
    for (int bit = 31; bit >= 0; --bit) {
        const unsigned cand = prefix | (1u << bit);
        int cnt = 0;
#pragma unroll
        for (int gq = 0; gq < 5; ++gq) if (gq * 16 < nj) {
#pragma unroll
            for (int jj = 0; jj < 16; ++jj) { const int j = gq * 16 + jj; if (j < 66) cnt += __popcll(__ballot(key[j] >= cand)); }
        }
        if (cnt >= 256) { prefix = cand; if (cnt == 256) { exact = true; break; } }
    }
    const unsigned thr = prefix;
    int need = 1 << 30;
    if (!exact) { int cgt = 0;
#pragma unroll
        for (int j = 0; j < 66; ++j) if (j < nj) cgt += __popcll(__ballot(key[j] > thr));
        need = 256 - cgt; }
    int eqb = 0;
#pragma unroll
    for (int j = 0; j < 66; ++j) if (j < nj) {
        const bool gt = key[j] > thr, eq = key[j] == thr;
        const unsigned long long em = __ballot(eq);
        const int rank = eqb + (int)__builtin_amdgcn_mbcnt_hi((unsigned)(em >> 32), __builtin_amdgcn_mbcnt_lo((unsigned)em, 0u));
        const bool sel = gt || (eq && rank < need);
        const unsigned long long sm = __ballot(sel);
        if (lane == 0) brow[j] = sm;
        eqb += __popcll(em);
    }
}

__device__ __forceinline__ void idx_item(int b, int g, const bf16_t* QI, const bf16_t* KI, const float* WI, unsigned* BITS, LAS unsigned char* lds, int tid, int wave, int lane) {
    LAS float* S = (LAS float*)lds; LAS unsigned* HIST = (LAS unsigned*)(lds + P2_HIST); LAS float* RS = (LAS float*)(lds + P2_RS);
    LAS unsigned* CAND = (LAS unsigned*)(lds + P2_CAND); LAS unsigned* CIDX = (LAS unsigned*)(lds + P2_CIDX);
    const int t0 = 8 * g; const int nj = t0 / 64 + 1; const int NT32 = 2 * nj;
    const int m = lane & 31, hh = lane >> 5;
#pragma unroll
    for (int i = 0; i < 8; ++i) HIST[tid + 512 * i] = 0u;
    if (tid < 8) { const float* wp = WI + (size_t)(b * LP + t0 + tid) * 8; const f32x4 lo = *(const f32x4*)wp, hi = *(const f32x4*)(wp + 4);
        const float ss = (lo[0] * lo[0] + lo[1] * lo[1]) + (lo[2] * lo[2] + lo[3] * lo[3]) + (hi[0] * hi[0] + hi[1] * hi[1]) + (hi[2] * hi[2] + hi[3] * hi[3]);
        RS[tid] = 32.0f / sqrtf(0.5f * ss + 1e-20f); }
    {
        const int aq = 2 * ((m >> 2) & 1) + (m >> 4), ah = 4 * ((m >> 3) & 1) + (m & 3);
        bf16x8 af[2][4];
#pragma unroll
        for (int mb = 0; mb < 2; ++mb)
#pragma unroll
            for (int ks = 0; ks < 4; ++ks) af[mb][ks] = *(const bf16x8*)(QI + (size_t)(b * LP + t0 + 4 * mb + aq) * 512 + ah * 64 + ks * 16 + hh * 8);
        float wv[2][2][8];
#pragma unroll
        for (int mb = 0; mb < 2; ++mb)
#pragma unroll
            for (int qq = 0; qq < 2; ++qq) { const size_t row = (size_t)(b * LP + t0 + 4 * mb + 2 * hh + qq);
                const f32x4 lo = *(const f32x4*)(WI + row * 8), hi = *(const f32x4*)(WI + row * 8 + 4);
                wv[mb][qq][0] = lo[0]; wv[mb][qq][1] = lo[1]; wv[mb][qq][2] = lo[2]; wv[mb][qq][3] = lo[3];
                wv[mb][qq][4] = hi[0]; wv[mb][qq][5] = hi[1]; wv[mb][qq][6] = hi[2]; wv[mb][qq][7] = hi[3]; }
        const bf16_t* kbase = KI + (size_t)(b * LP + m) * 64 + hh * 8;
#define IDX_LOADB(dst, tile) do { _Pragma("unroll") for (int ks = 0; ks < 4; ++ks) dst[ks] = *(const bf16x8*)(kbase + (size_t)(32 * (tile)) * 64 + ks * 16); } while (0)
        bf16x8 kb0[4], kb1[4], kb2[4];
        for (int rsc_ = 0; rsc_ < REP_SCORE; ++rsc_) {
        const bool dh = (rsc_ == REP_SCORE - 1);
        int tl = wave;
        if (tl < NT32) IDX_LOADB(kb0, tl);
        if (tl + 8 < NT32) IDX_LOADB(kb1, tl + 8);
        if (tl + 16 < NT32) IDX_LOADB(kb2, tl + 16);
        __syncthreads();
        float rsv[2][2];
#pragma unroll
        for (int mb = 0; mb < 2; ++mb)
#pragma unroll
            for (int qq = 0; qq < 2; ++qq) rsv[mb][qq] = RS[4 * mb + 2 * hh + qq];
#define IDX_TILE(kb, tile) do { \
            const int s = 32 * (tile) + m; \
            f32x16 c0 = {}, c1 = {}; \
            _Pragma("unroll") for (int ks = 0; ks < 4; ++ks) { c0 = __builtin_amdgcn_mfma_f32_32x32x16_bf16(af[0][ks], kb[ks], c0, 0, 0, 0); c1 = __builtin_amdgcn_mfma_f32_32x32x16_bf16(af[1][ks], kb[ks], c1, 0, 0, 0); } \
            if ((tile) + 24 < NT32) IDX_LOADB(kb, (tile) + 24); \
            _Pragma("unroll") for (int qq = 0; qq < 2; ++qq) { \
                float s0 = 0.f, s1 = 0.f;     \
                _Pragma("unroll") for (int h = 0; h < 8; ++h) { s0 = fmaf(wv[0][qq][h], __builtin_amdgcn_fmed3f(c0[8 * qq + h], 0.f, 3.0e38f), s0); s1 = fmaf(wv[1][qq][h], __builtin_amdgcn_fmed3f(c1[8 * qq + h], 0.f, 3.0e38f), s1); } \
                const int q0 = 2 * hh + qq, q1 = 4 + 2 * hh + qq; \
                if (s <= t0 + q0) { if (dh) __hip_atomic_fetch_add(HIST + q0 * 512 + score_bin(s0, rsv[0][qq]), 1u, __ATOMIC_RELAXED, __HIP_MEMORY_SCOPE_WORKGROUP); } else s0 = -INFINITY; \
                if (s <= t0 + q1) { if (dh) __hip_atomic_fetch_add(HIST + q1 * 512 + score_bin(s1, rsv[1][qq]), 1u, __ATOMIC_RELAXED, __HIP_MEMORY_SCOPE_WORKGROUP); } else s1 = -INFINITY; \
                S[q0 * SSTR + s] = s0; S[q1 * SSTR + s] = s1; \
            } } while (0)
        for (; tl < NT32; tl += 24) {
            IDX_TILE(kb0, tl);
            if (tl + 8 < NT32) IDX_TILE(kb1, tl + 8);
            if (tl + 16 < NT32) IDX_TILE(kb2, tl + 16);
        }
        }
#undef IDX_TILE
#undef IDX_LOADB
    }
    __syncthreads();
    for (int rse_ = 0; rse_ < REP_SEL; ++rse_) {
        const int t = t0 + wave;
        const LAS float* Sr = S + wave * SSTR;
        unsigned long long* brow = (unsigned long long*)(BITS + (size_t)(b * LP + t) * BW);
        if (t < 256) {
            for (int j = 0; j < nj; ++j) { const unsigned long long mk = __ballot((64 * j + lane) <= t); if (lane == 0) brow[j] = mk; }
        } else {
            const LAS unsigned* H = HIST + wave * 512;
            const u32x4 ha = *(const LAS u32x4*)(H + 8 * lane), hb = *(const LAS u32x4*)(H + 8 * lane + 4);
            const unsigned lsum = (ha.x + ha.y) + (ha.z + ha.w) + (hb.x + hb.y) + (hb.z + hb.w);
            unsigned incl = lsum;
#pragma unroll
            for (int o = 1; o < 64; o <<= 1) { const unsigned v = __shfl_down(incl, o); if (lane + o < 64) incl += v; }
            unsigned cum = incl - lsum; int Bsel = -1; unsigned cab = 0u;
#define P2_STEP(hv, i) do { if (Bsel < 0 && cum < 256u && cum + (hv) >= 256u) { Bsel = 8 * lane + (i); cab = cum; } cum += (hv); } while (0)
            P2_STEP(hb.w, 7); P2_STEP(hb.z, 6); P2_STEP(hb.y, 5); P2_STEP(hb.x, 4); P2_STEP(ha.w, 3); P2_STEP(ha.z, 2); P2_STEP(ha.y, 1); P2_STEP(ha.x, 0);
#undef P2_STEP
            const unsigned long long fm = __ballot(Bsel >= 0);
            const int src = (int)__ffsll((unsigned long long)fm) - 1;
            const int Bb = __builtin_amdgcn_readlane(Bsel, src);
            const int c_above = __builtin_amdgcn_readlane((int)cab, src);
            const int cB = (int)H[Bb];
            const int rr = 256 - c_above;
            if (fm == 0ull || cB > 64 || rr < 1 || rr > cB) {
                select_bisect(Sr, brow, nj, lane);
            } else {
                const float rs = RS[wave];
                const float hiT = (Bb >= 511) ? INFINITY : (float)(Bb + 1), loT = (Bb <= 0) ? -INFINITY : (float)Bb;
                const int jt = t >> 6; const unsigned long long tailm = (~0ull) >> (63 - (t & 63));
                unsigned long long w0 = 0ull, w1 = 0ull;
                int cnt = 0;
#define SEL_CHUNK(fv, j, vm) do { \
                        const float vv = __builtin_fmaf((fv), rs, 256.0f); \
                        const unsigned long long mh = __ballot(vv >= hiT) & (vm); \
                        const unsigned long long mc = __ballot(vv >= loT) & (vm) & ~mh; \
                        if (lane == ((j) & 63)) { if ((j) < 64) w0 = mh; else w1 = mh; } \
                        if (mc != 0ull) { \
                            const bool is = (mc >> lane) & 1ull; \
                            const int pos = cnt + (int)__builtin_amdgcn_mbcnt_hi((unsigned)(mc >> 32), __builtin_amdgcn_mbcnt_lo((unsigned)mc, 0u)); \
                            if (is && pos < 64) { CAND[wave * 64 + pos] = ord_key(fv); CIDX[wave * 64 + pos] = (unsigned)(64 * (j) + lane); } \
                            cnt += __popcll(mc); \
                        } } while (0)
                int j0 = 0;
                for (; j0 + 4 <= jt; j0 += 4) {
                    float f4[4];
#pragma unroll
                    for (int i = 0; i < 4; ++i) f4[i] = Sr[64 * (j0 + i) + lane];
#pragma unroll
                    for (int i = 0; i < 4; ++i) SEL_CHUNK(f4[i], j0 + i, ~0ull);
                }
                for (; j0 <= jt; ++j0) {
                    const float f1 = Sr[64 * j0 + lane];
                    const unsigned long long vm = (j0 < jt) ? ~0ull : tailm;
                    SEL_CHUNK(f1, j0, vm);
                }
#undef SEL_CHUNK
                asm volatile("s_waitcnt lgkmcnt(0)" ::: "memory");
                const unsigned myk = (lane < cB) ? CAND[wave * 64 + lane] : 0u;
                const unsigned myi = (lane < cB) ? CIDX[wave * 64 + lane] : 0u;
                int rank = 0;
                for (int jj = 0; jj < cB; ++jj) { const unsigned kj = (unsigned)__builtin_amdgcn_readlane((int)myk, jj); rank += ((kj > myk) || (kj == myk && jj < lane)) ? 1 : 0; }
                unsigned long long chosen = __ballot(lane < cB && rank < rr);
                while (chosen != 0ull) {
                    const int c = (int)__ffsll((unsigned long long)chosen) - 1; chosen &= chosen - 1ull;
                    const unsigned ci = (unsigned)__builtin_amdgcn_readlane((int)myi, c);
                    const int jc = (int)(ci >> 6); const unsigned long long bit = 1ull << (ci & 63u);
                    if (lane == (jc & 63)) { if (jc < 64) w0 |= bit; else w1 |= bit; }
                }
                if (lane < nj) brow[lane] = w0;
                if (lane < 2 && 64 + lane < nj) brow[64 + lane] = w1;
            }
        }
    }
    __syncthreads();
}

__device__ __forceinline__ void conv_tile(int b, int ti, const bf16_t* U, const bf16_t* ZC, const float* cw, const float* cb, const float* lg, const float* lb,
                                          bf16_t* YMIX, LAS float* C, int tid, int wave, int lane) {
    const int t0 = 32 * ti;
    {
        const int cp = tid & 255, rh = tid >> 8;
        float w0[31], w1[31];
#pragma unroll
        for (int j = 0; j < 31; ++j) { const f32x2 ww = *(const f32x2*)(cw + j * 512 + 2 * cp); w0[j] = ww[0]; w1[j] = ww[1]; }
        const f32x2 bias = *(const f32x2*)(cb + 2 * cp);
        float x0[46], x1[46];
#pragma unroll
        for (int i = 0; i < 46; ++i) { const int t = t0 - 30 + 16 * rh + i; x0[i] = 0.f; x1[i] = 0.f;
            if (t >= 0) { const unsigned pu = *(const unsigned*)(U + (size_t)(b * LP + t) * 512 + 2 * cp); x0[i] = bflo(pu); x1[i] = bfhi(pu); } }
#pragma unroll
        for (int o = 0; o < 16; ++o) { float a0 = bias[0], a1 = bias[1];
#pragma unroll
            for (int j = 0; j < 31; ++j) { a0 = fmaf(w0[j], x0[o + j], a0); a1 = fmaf(w1[j], x1[o + j], a1); }
            f32x2 r2; r2[0] = a0; r2[1] = a1; *(LAS f32x2*)(C + (16 * rh + o) * 512 + 2 * cp) = r2; }
    }
    const f32x4 g0 = *(const f32x4*)(lg + lane * 8), g1 = *(const f32x4*)(lg + lane * 8 + 4), b0 = *(const f32x4*)(lb + lane * 8), b1 = *(const f32x4*)(lb + lane * 8 + 4);
    u32x4 zz[4];
#pragma unroll
    for (int rr = 0; rr < 4; ++rr) zz[rr] = *(const u32x4*)(ZC + (size_t)(b * LP + t0 + 4 * wave + rr) * 512 + lane * 8);
    asm volatile("s_waitcnt lgkmcnt(0)\n\ts_barrier" ::: "memory");
    {
        f32x4 a0[4], a1[4]; float sm[4], sq[4];
#pragma unroll
        for (int rr = 0; rr < 4; ++rr) { const LAS float* cr = C + (4 * wave + rr) * 512 + lane * 8; a0[rr] = *(const LAS f32x4*)cr; a1[rr] = *(const LAS f32x4*)(cr + 4);
            sm[rr] = (a0[rr][0] + a0[rr][1]) + (a0[rr][2] + a0[rr][3]) + (a1[rr][0] + a1[rr][1]) + (a1[rr][2] + a1[rr][3]); }
#pragma unroll
        for (int o = 1; o < 64; o <<= 1) {
#pragma unroll
            for (int rr = 0; rr < 4; ++rr) sm[rr] += __shfl_xor(sm[rr], o); }
#pragma unroll
        for (int rr = 0; rr < 4; ++rr) { const float mean = sm[rr] * (1.f / 512.f); a0[rr] = a0[rr] - mean; a1[rr] = a1[rr] - mean;
            sq[rr] = (a0[rr][0] * a0[rr][0] + a0[rr][1] * a0[rr][1]) + (a0[rr][2] * a0[rr][2] + a0[rr][3] * a0[rr][3]) + (a1[rr][0] * a1[rr][0] + a1[rr][1] * a1[rr][1]) + (a1[rr][2] * a1[rr][2] + a1[rr][3] * a1[rr][3]); }
#pragma unroll
        for (int o = 1; o < 64; o <<= 1) {
#pragma unroll
            for (int rr = 0; rr < 4; ++rr) sq[rr] += __shfl_xor(sq[rr], o); }
#pragma unroll
        for (int rr = 0; rr < 4; ++rr) {
            const float rstd = 1.0f / sqrtf(sq[rr] * (1.f / 512.f) + LN_EPS);
            const size_t row = (size_t)(b * LP + t0 + 4 * wave + rr);
            const u32x4 z = zz[rr];
            const f32x4 y0 = a0[rr] * rstd * g0 + b0, y1 = a1[rr] * rstd * g1 + b1;
            u32x4 w;
            w.x = pk2(y0[0] * sigmoidf_(y0[0]) * bflo(z.x), y0[1] * sigmoidf_(y0[1]) * bfhi(z.x));
            w.y = pk2(y0[2] * sigmoidf_(y0[2]) * bflo(z.y), y0[3] * sigmoidf_(y0[3]) * bfhi(z.y));
            w.z = pk2(y1[0] * sigmoidf_(y1[0]) * bflo(z.z), y1[1] * sigmoidf_(y1[1]) * bfhi(z.z));
            w.w = pk2(y1[2] * sigmoidf_(y1[2]) * bflo(z.w), y1[3] * sigmoidf_(y1[3]) * bfhi(z.w));
            *(u32x4*)(YMIX + row * 1024 + lane * 8) = w;
        }
    }
    asm volatile("s_waitcnt lgkmcnt(0)\n\ts_barrier" ::: "memory");
}

constexpr int KSTR = 272, VSTR = 320;
typedef short v4i16_t __attribute__((ext_vector_type(4)));
__device__ __forceinline__ float vmax3(float a, float b, float c) { float r; asm("v_max3_f32 %0, %1, %2, %3" : "=v"(r) : "v"(a), "v"(b), "v"(c)); return r; }
#define bfe1(w, c) ({ unsigned m_; asm("v_bfe_i32 %0, %1, %2, 1" : "=v"(m_) : "v"(w), "n"(c)); m_; })
__device__ __forceinline__ void attn_unit(int b, int hp, int qb, const bf16_t* Q, const bf16_t* K, const bf16_t* V, const bf16_t* ZA, const unsigned* BITS, bf16_t* YMIX,
                                          LAS unsigned char* lds, int tid, int wave, int lane) {
    const int hl = wave >> 2, h = 2 * hp + hl;
    const int q0 = 128 * qb, qw0 = q0 + 32 * (wave & 3);
    const int n = lane & 31, hh = lane >> 5;
    const size_t qrow = (size_t)(b * LP + qw0 + n);
    bf16x8 qf[4];
#pragma unroll
    for (int ks = 0; ks < 4; ++ks) qf[ks] = *(const bf16x8*)(Q + qrow * 512 + h * 64 + ks * 16 + hh * 8);
    const int NT = 2 * qb + 2;
    LAS unsigned char* Ks = lds; LAS unsigned char* Vs = lds + 2 * 64 * KSTR;
    const int r0 = tid >> 4, ch = tid & 15;
    const size_t gb = (size_t)(b * LP) * 512 + hp * 128 + ch * 8;
    u32x4 kA0, kA1, vA0, vA1, kB0, kB1, vB0, vB1;
#define ATT_LOAD(tile, k0, k1, v0, v1) do { const size_t ro = gb + (size_t)(64 * (tile) + r0) * 512; k0 = *(const u32x4*)(K + ro); k1 = *(const u32x4*)(K + ro + 32 * 512); v0 = *(const u32x4*)(V + ro); v1 = *(const u32x4*)(V + ro + 32 * 512); } while (0)
#define ATT_STORE(buf, k0, k1, v0, v1) do { *(LAS u32x4*)(Ks + (buf) * 64 * KSTR + r0 * KSTR + ch * 16) = k0; *(LAS u32x4*)(Ks + (buf) * 64 * KSTR + (r0 + 32) * KSTR + ch * 16) = k1; \
        *(LAS u32x4*)(Vs + (buf) * 64 * VSTR + r0 * VSTR + ch * 16) = v0; *(LAS u32x4*)(Vs + (buf) * 64 * VSTR + (r0 + 32) * VSTR + ch * 16) = v1; } while (0)
#define ATT_BAR() asm volatile("s_waitcnt lgkmcnt(0)\n\ts_barrier" ::: "memory")
    const unsigned long long* mrow = (const unsigned long long*)(BITS + qrow * BW);
    ATT_LOAD(0, kA0, kA1, vA0, vA1); ATT_LOAD(1, kB0, kB1, vB0, vB1);
    ATT_STORE(0, kA0, kA1, vA0, vA1);
    if (NT > 2) ATT_LOAD(2, kA0, kA1, vA0, vA1);
    unsigned long long mwA = mrow[0], mwB = mrow[1];
    ATT_BAR();
    float mrun = 0.f, lrun = 0.f; f32x16 o0 = {}, o1 = {}, negm = {};
    const int qq4 = (lane & 15) >> 2, pp = lane & 3, blk = (lane >> 4) & 1;
    for (int tile2 = 0; tile2 < NT; tile2 += 2) {
#pragma unroll
        for (int half = 0; half < 2; ++half) {
            const int tile = tile2 + half; const int buf = half;
            const unsigned long long mw = half ? mwB : mwA;
            if (64 * tile <= qw0 + 31 && qw0 < LV) {
            f32x16 s0 = negm, s1 = negm;
            const LAS unsigned char* kb = Ks + buf * 64 * KSTR + n * KSTR + hl * 128 + hh * 16;
            bf16x8 kf0[4], kf1[4];
#pragma unroll
            for (int ks = 0; ks < 4; ++ks) { kf0[ks] = *(const LAS bf16x8*)(kb + ks * 32); kf1[ks] = *(const LAS bf16x8*)(kb + 32 * KSTR + ks * 32); }
            __builtin_amdgcn_sched_barrier(0);
#pragma unroll
            for (int ks = 0; ks < 4; ++ks) {
                s0 = __builtin_amdgcn_mfma_f32_32x32x16_bf16(kf0[ks], qf[ks], s0, 0, 0, 0);
                s1 = __builtin_amdgcn_mfma_f32_32x32x16_bf16(kf1[ks], qf[ks], s1, 0, 0, 0);
            }
            const LAS unsigned char* vb = Vs + buf * 64 * VSTR + (4 * hh + qq4) * VSTR + (hl * 64 + 16 * blk + 4 * pp) * 2;
            s16x4 vlo[2][2][2], vhi[2][2][2];
#pragma unroll
            for (int mb = 0; mb < 2; ++mb)
#pragma unroll
                for (int ks = 0; ks < 2; ++ks)
#pragma unroll
                    for (int db = 0; db < 2; ++db) {
                        const LAS unsigned char* vk = vb + (32 * mb + 16 * ks) * VSTR;
                        vlo[mb][ks][db] = __builtin_bit_cast(s16x4, __builtin_amdgcn_ds_read_tr16_b64_v4i16((LAS v4i16_t*)(vk + db * 64)));
                        vhi[mb][ks][db] = __builtin_bit_cast(s16x4, __builtin_amdgcn_ds_read_tr16_b64_v4i16((LAS v4i16_t*)(vk + 8 * VSTR + db * 64)));
                    }
            __builtin_amdgcn_sched_barrier(0);
            float mxa = fmaxf(s0[0], s1[0]), mxb = fmaxf(s0[1], s1[1]);
#pragma unroll
            for (int r = 2; r < 16; r += 2) { mxa = vmax3(mxa, s0[r], s1[r]); mxb = vmax3(mxb, s0[r + 1], s1[r + 1]); }
            float mx = fmaxf(mxa, mxb);
            if (__any(mx > 6.0f)) {
                mx = fmaxf(mx, __shfl_xor(mx, 32));
                const float dl = fmaxf(mx, 0.f);
                mrun += dl;
                const float alpha = __builtin_amdgcn_exp2f(-dl);
                lrun *= alpha;
#pragma unroll
                for (int r = 0; r < 16; ++r) { s0[r] -= dl; s1[r] -= dl; o0[r] *= alpha; o1[r] *= alpha; negm[r] = -mrun; }
            }
            const int wl = (int)((unsigned)mw >> (4 * hh)), wh = (int)((unsigned)(mw >> 32) >> (4 * hh));
            f32x2 ps2 = {0.f, 0.f};
#pragma unroll
            for (int r = 0; r < 16; r += 2) {
                const int c0b = (r & 3) + 8 * (r >> 2), c1b = ((r + 1) & 3) + 8 * ((r + 1) >> 2);
                const float a0 = __uint_as_float(__float_as_uint(__builtin_amdgcn_exp2f(s0[r])) & bfe1(wl, c0b));
                const float a1 = __uint_as_float(__float_as_uint(__builtin_amdgcn_exp2f(s0[r + 1])) & bfe1(wl, c1b));
                const float b0 = __uint_as_float(__float_as_uint(__builtin_amdgcn_exp2f(s1[r])) & bfe1(wh, c0b));
                const float b1 = __uint_as_float(__float_as_uint(__builtin_amdgcn_exp2f(s1[r + 1])) & bfe1(wh, c1b));
                s0[r] = a0; s0[r + 1] = a1; s1[r] = b0; s1[r + 1] = b1;
                ps2 += (f32x2){a0, a1}; ps2 += (f32x2){b0, b1};
            }
            lrun += ps2[0] + ps2[1];
            __builtin_amdgcn_sched_barrier(0);
#pragma unroll
            for (int mb = 0; mb < 2; ++mb)
#pragma unroll
                for (int ks = 0; ks < 2; ++ks) {
                    bf16x8 pf;
                    { u32x4 pw;
                      if (mb == 0) { pw.x = pk2(s0[8 * ks + 0], s0[8 * ks + 1]); pw.y = pk2(s0[8 * ks + 2], s0[8 * ks + 3]); pw.z = pk2(s0[8 * ks + 4], s0[8 * ks + 5]); pw.w = pk2(s0[8 * ks + 6], s0[8 * ks + 7]); }
                      else         { pw.x = pk2(s1[8 * ks + 0], s1[8 * ks + 1]); pw.y = pk2(s1[8 * ks + 2], s1[8 * ks + 3]); pw.z = pk2(s1[8 * ks + 4], s1[8 * ks + 5]); pw.w = pk2(s1[8 * ks + 6], s1[8 * ks + 7]); }
                      pf = __builtin_bit_cast(bf16x8, pw); }
#pragma unroll
                    for (int db = 0; db < 2; ++db) {
                        const s16x4 lo = vlo[mb][ks][db], hi = vhi[mb][ks][db];
                        const bf16x8 vf = (bf16x8){lo[0], lo[1], lo[2], lo[3], hi[0], hi[1], hi[2], hi[3]};
                        if (db == 0) o0 = __builtin_amdgcn_mfma_f32_32x32x16_bf16(vf, pf, o0, 0, 0, 0);
                        else         o1 = __builtin_amdgcn_mfma_f32_32x32x16_bf16(vf, pf, o1, 0, 0, 0);
                    }
                }
            }
            if (half == 0) {
                ATT_STORE(1, kB0, kB1, vB0, vB1);
                if (tile + 3 < NT) ATT_LOAD(tile + 3, kB0, kB1, vB0, vB1);
                if (tile + 2 < NT) mwA = mrow[tile + 2];
            } else {
                if (tile + 1 < NT) { ATT_STORE(0, kA0, kA1, vA0, vA1); if (tile + 3 < NT) ATT_LOAD(tile + 3, kA0, kA1, vA0, vA1); }
                if (tile + 2 < NT) mwB = mrow[tile + 2];
            }
            ATT_BAR();
        }
    }
#undef ATT_LOAD
#undef ATT_STORE
#undef ATT_BAR
    lrun += __shfl_xor(lrun, 32);
    const float inv = 1.0f / lrun;
#pragma unroll
    for (int db = 0; db < 2; ++db)
#pragma unroll
        for (int g4 = 0; g4 < 4; ++g4) {
            const int d0 = 32 * db + 8 * g4 + 4 * hh;
            const u32x2 z = *(const u32x2*)(ZA + qrow * 512 + h * 64 + d0);
            float v0, v1, v2, v3;
            if (db == 0) { v0 = o0[4 * g4]; v1 = o0[4 * g4 + 1]; v2 = o0[4 * g4 + 2]; v3 = o0[4 * g4 + 3]; } else { v0 = o1[4 * g4]; v1 = o1[4 * g4 + 1]; v2 = o1[4 * g4 + 2]; v3 = o1[4 * g4 + 3]; }
            u32x2 w; w.x = pk2(v0 * inv * bflo(z.x), v1 * inv * bfhi(z.x)); w.y = pk2(v2 * inv * bflo(z.y), v3 * inv * bfhi(z.y));
            *(u32x2*)(YMIX + qrow * 1024 + 512 + h * 64 + d0) = w;
        }
}

__device__ __forceinline__ void ln_phase(const Params& p, int l, int wave, int lane) {
    const int gw = blockIdx.x * 8 + wave, NGW = gridDim.x * 8;
    bf16_t* HB = (bf16_t*)(p.ws + WS_HB); float* METAH = (float*)(p.ws + WS_METAH);
    const float* G = p.post_g + l * 1024; const float* Bv = p.post_b + l * 1024;
    f32x4 gg[4], bb[4];
#pragma unroll
    for (int j = 0; j < 4; ++j) { gg[j] = *((const f32x4*)G + lane + 64 * j); bb[j] = *((const f32x4*)Bv + lane + 64 * j); }
    constexpr int NGRP = NB * LV / 4;
    for (int g = gw; g < NGRP; g += NGW) {
        const int v0 = 4 * g; const int b = v0 / LV, t0 = v0 - b * LV;
        float* hp[4]; f32x4 v[4][4]; float s[4], q[4];
#pragma unroll
        for (int i = 0; i < 4; ++i) { const int t = t0 + i; hp[i] = (t < NMETA) ? (METAH + (size_t)(b * NMETA + t) * 1024) : (p.out + ((size_t)b * SEQ + (t - NMETA)) * 1024); }
#pragma unroll
        for (int i = 0; i < 4; ++i) { s[i] = 0.f;
#pragma unroll
            for (int j = 0; j < 4; ++j) { v[i][j] = *((const f32x4*)hp[i] + lane + 64 * j); } }
#pragma unroll
        for (int i = 0; i < 4; ++i)
#pragma unroll
            for (int j = 0; j < 4; ++j) s[i] += (v[i][j][0] + v[i][j][1]) + (v[i][j][2] + v[i][j][3]);
#pragma unroll
        for (int o = 1; o < 64; o <<= 1) {
#pragma unroll
            for (int i = 0; i < 4; ++i) s[i] += __shfl_xor(s[i], o); }
#pragma unroll
        for (int i = 0; i < 4; ++i) { const float mean = s[i] * (1.f / 1024.f); s[i] = mean; q[i] = 0.f;
#pragma unroll
            for (int j = 0; j < 4; ++j) { v[i][j] = v[i][j] - mean; q[i] += (v[i][j][0] * v[i][j][0] + v[i][j][1] * v[i][j][1]) + (v[i][j][2] * v[i][j][2] + v[i][j][3] * v[i][j][3]); } }
#pragma unroll
        for (int o = 1; o < 64; o <<= 1) {
#pragma unroll
            for (int i = 0; i < 4; ++i) q[i] += __shfl_xor(q[i], o); }
#pragma unroll
        for (int i = 0; i < 4; ++i) {
            const float rstd = 1.0f / sqrtf(q[i] * (1.f / 1024.f) + LN_EPS);
            const size_t r = (size_t)(b * LP + t0 + i);
            u32x2* o = (u32x2*)(HB + r * 1024) + lane;
            if (lane == 0 && l < DEPTH - 1) { f32x2 st; st[0] = s[i]; st[1] = rstd; *(f32x2*)((float*)(p.ws + WS_STAT) + r * 2) = st; }
#pragma unroll
            for (int j = 0; j < 4; ++j) { const f32x4 y = v[i][j] * rstd * gg[j] + bb[j]; if (l == DEPTH - 1) *((f32x4*)hp[i] + lane + 64 * j) = y;
                if (l < DEPTH - 1) { u32x2 w; w.x = pk2(y[0], y[1]); w.y = pk2(y[2], y[3]); o[64 * j] = w; } }
        }
    }
}

#define XB_TMO      128
#define XB_XCNT(j)  (256  + 64 * (j))
#define XB_XSUB(j)  (1280 + 64 * (j))
#define XB_XGEN(j)  (2304 + 64 * (j))
#define XB_TOP      3328
#define XB_TOPGEN   3392
#define XCD_BAR_WORDS 3456
#define XB_SPIN_CAP (1u << 18)

__device__ __forceinline__ unsigned xb_ld(unsigned* p)              { return __hip_atomic_load(p, __ATOMIC_RELAXED, __HIP_MEMORY_SCOPE_AGENT); }
__device__ __forceinline__ unsigned xb_add(unsigned* p, unsigned v) { return __hip_atomic_fetch_add(p, v, __ATOMIC_RELAXED, __HIP_MEMORY_SCOPE_AGENT); }
__device__ __forceinline__ unsigned xb_xcc_id() { return (unsigned)__builtin_amdgcn_s_getreg((3 << 11) | 20) & 0xFu; }
#define XB_SPIN(cond, bar) do { unsigned _sp = 0; while (cond) { __builtin_amdgcn_s_sleep(1); \
    if ((++_sp & 255u) == 0u) { if (xb_ld(&(bar)[XB_TMO])) break; if (_sp > XB_SPIN_CAP) { atomicAdd(&(bar)[XB_TMO], 1u); break; } } } } while (0)

struct XcdBarrier {
    unsigned* bar; unsigned x;
    volatile LAS unsigned* st;
};

__device__ __forceinline__ XcdBarrier xcd_barrier_post(unsigned* bar, volatile LAS unsigned* st) {
    XcdBarrier b; b.bar = bar; b.x = xb_xcc_id(); b.st = st;
    if (threadIdx.x == 0) (void)xb_add(&bar[XB_XCNT(b.x)], 1u);
    return b;
}
__device__ __forceinline__ void xcd_barrier_complete(unsigned* bar, unsigned x, unsigned& nloc, unsigned& nx) {
    const unsigned G = gridDim.x * gridDim.y * gridDim.z;
    unsigned sum, cnt, mine, sp = 0u;
    for (;;) {
        sum = 0u; cnt = 0u; mine = 0u;
#pragma unroll
        for (unsigned j = 0; j < 16; ++j) { const unsigned c = xb_ld(&bar[XB_XCNT(j)]); sum += c; cnt += (c > 0u) ? 1u : 0u; mine = (j == x) ? c : mine; }
        if (sum == G) break;
        __builtin_amdgcn_s_sleep(1);
        if ((++sp & 255u) == 0u) { if (xb_ld(&bar[XB_TMO])) break; if (sp > XB_SPIN_CAP) { atomicAdd(&bar[XB_TMO], 1u); break; } }
    }
    nloc = mine > 0u ? mine : 1u; nx = cnt > 0u ? cnt : 1u;
}

__device__ __forceinline__ void xcd_barrier(const XcdBarrier& b) {
    asm volatile("s_waitcnt vmcnt(0)" ::: "memory");
    __syncthreads();
    if (threadIdx.x == 0) {
        unsigned* bar = b.bar;
        __builtin_amdgcn_s_waitcnt(0);
        unsigned nloc = b.st[0], nx = b.st[1];
        if (nloc == 0u) { xcd_barrier_complete(bar, b.x, nloc, nx); b.st[0] = nloc; b.st[1] = nx; }
        const unsigned old = xb_add(&bar[XB_XSUB(b.x)], 1u);
        const unsigned gen = old / nloc;
        if (old + 1u == (gen + 1u) * nloc) {
            __builtin_amdgcn_fence(__ATOMIC_RELEASE, "agent");
            asm volatile("s_waitcnt vmcnt(0)" ::: "memory");
            const unsigned og = xb_add(&bar[XB_TOP], 1u);
            const unsigned tg = og / nx;
            if (og + 1u == (tg + 1u) * nx) xb_add(&bar[XB_TOPGEN], 1u);
            else XB_SPIN(xb_ld(&bar[XB_TOPGEN]) == tg, bar);
            __builtin_amdgcn_fence(__ATOMIC_ACQUIRE, "agent");
            xb_add(&bar[XB_XGEN(b.x)], 1u);
            asm volatile("s_waitcnt vmcnt(0)" ::: "memory");
        } else {
            XB_SPIN(xb_ld(&bar[XB_XGEN(b.x)]) == gen, bar);
            __builtin_amdgcn_fence(__ATOMIC_ACQUIRE, "agent");
            asm volatile("s_waitcnt vmcnt(0)" ::: "memory");
        }
    }
    __syncthreads();
}

#ifndef REP_P2
#define REP_P2 1
#endif
#ifndef REP_IDX
#define REP_IDX 1
#endif
#ifndef REP_CONV
#define REP_CONV 1
#endif
#ifndef REP_P0
#define REP_P0 1
#endif
#ifndef REP_SYNC
#define REP_SYNC 0
#endif
#ifndef REP_P3
#define REP_P3 1
#endif
#ifndef REP_G1
#define REP_G1 1
#endif
__global__ void __launch_bounds__(512, 2) fwd_megakernel(Params p) {
    extern __shared__ __attribute__((aligned(16))) unsigned char lds_raw[];
    cg::grid_group grid = cg::this_grid();
    LAS unsigned char* lds = (LAS unsigned char*)lds_raw;
    const int tid = threadIdx.x, lane = tid & 63, wave = __builtin_amdgcn_readfirstlane(tid >> 6);
    const int G = gridDim.x, bx = blockIdx.x;
    unsigned char* ws = p.ws;
    bf16_t* HB = (bf16_t*)(ws + WS_HB);
    bf16_t *U = (bf16_t*)(ws + WS_U), *ZC = (bf16_t*)(ws + WS_ZC), *Q = (bf16_t*)(ws + WS_Q), *K = (bf16_t*)(ws + WS_K), *V = (bf16_t*)(ws + WS_V),
           *ZA = (bf16_t*)(ws + WS_ZA), *QI = (bf16_t*)(ws + WS_QI), *KI = (bf16_t*)(ws + WS_KI), *YMIX = (bf16_t*)(ws + WS_YMIX);
    float* WI = (float*)(ws + WS_WI); unsigned* BITS = (unsigned*)(ws + WS_BITS); float* METAH = (float*)(ws + WS_METAH);
    const float* cosT = (const float*)(ws + WS_COS); const float* sinT = (const float*)(ws + WS_SIN);

    if (tid < 16) ((LAS unsigned*)(lds + LDS_BYTES - 64))[tid] = 0u;
    __syncthreads();
    const XcdBarrier xbar = xcd_barrier_post((unsigned*)(ws + WS_BAR), (volatile LAS unsigned*)(lds + LDS_BYTES - 64));
#define GSYNC() xcd_barrier(xbar)
    if (p.ws == nullptr) grid.sync();
#ifndef NO_P0
    for (int rp_ = 0; rp_ < REP_P0; ++rp_) p0_prologue(p, lds, wave, lane);
#endif
    GSYNC();
    for (int rs_ = 0; rs_ < REP_SYNC; ++rs_) GSYNC();

#define LAUNDER() int tid_ = tid, wave_ = wave; asm volatile("" : "+v"(tid_)); asm volatile("" : "+s"(wave_)); const int lane_ = tid_ & 63; (void)lane_; (void)wave_
#pragma unroll 1
    for (int l = 0; l < DEPTH; ++l) {
#ifndef NO_G1
        for (int rep_ = 0; rep_ < REP_G1; ++rep_) {
            pg8::Gemm g{HB, (const bf16_t*)(ws + WS_WIN) + (size_t)l * NPAD * 1024, NR, NPAD, 1024};
            pg8::StaticOrder S; S.init(NR, NPAD, G, bx);
            EpiIn E{U, ZC, Q, K, V, ZA, QI, KI, WI, cosT, sinT};
            pg8::gemm_phase<EpiIn, pg8::StaticOrder, true, true>(lds, g, S, E);
        }
#endif
        GSYNC();
#ifndef NO_P2
        for (int rep_ = 0; rep_ < REP_P2; ++rep_) {
            LAUNDER();
            constexpr int NITEM = NB * (LV / 8);
            for (int ri_ = 0; ri_ < REP_IDX; ++ri_)
            for (int k = 0; k * G < NITEM; ++k) {
                const int idx = (k & 1) ? (k * G + (G - 1 - bx)) : (k * G + bx);
                if (idx < NITEM) { const int g = (LV / 8 - 1) - idx / NB, b = idx % NB; idx_item(b, g, QI, KI, WI, BITS, lds, tid_, wave_, lane_); }
            }
            constexpr int NCT = NB * (LP / 32);
            for (int rc_ = 0; rc_ < REP_CONV; ++rc_)
            for (int ct = (G - 1 - bx); ct < NCT; ct += G) {
                const int b = ct / (LP / 32), ti = ct - b * (LP / 32);
                if (32 * ti >= LV) continue;
                conv_tile(b, ti, U, ZC, p.conv_w + (size_t)l * 31 * 512, p.conv_b + l * 512, p.conv_ln_g + l * 512, p.conv_ln_b + l * 512, YMIX, (LAS float*)lds, tid_, wave_, lane_);
            }
        }
#endif
        GSYNC();
#ifndef NO_P3
        for (int rep_ = 0; rep_ < REP_P3; ++rep_) {
            LAUNDER();
            constexpr int NU = NB * 4 * (LP / 128);
            for (int k = 0; k * G < NU; ++k) {
                const int idx = (k & 1) ? (k * G + (G - 1 - bx)) : (k * G + bx);
                if (idx < NU) { const int qb = (LP / 128 - 1) - idx / 32, bh = idx % 32; attn_unit(bh >> 2, bh & 3, qb, Q, K, V, ZA, BITS, YMIX, lds, tid_, wave_, lane_); }
            }
        }
#endif
        GSYNC();
#ifndef NO_G2
        {
            pg8::Gemm g{YMIX, (const bf16_t*)(ws + WS_WOUT) + (size_t)l * 1024 * 1024, NR, 1024, 1024};
            pg8::StaticOrder S; S.init(NR, 1024, G, bx);
            EpiOut E{l == 0 ? p.x : p.out, l == 0 ? p.meta : METAH, l == 0 ? 0 : NMETA * 1024, p.out, METAH,
                     l == 0 ? (const float*)nullptr : (const float*)(ws + WS_STAT), p.post_g + (l > 0 ? l - 1 : 0) * 1024, p.post_b + (l > 0 ? l - 1 : 0) * 1024, (float*)(ws + WS_DUMP)};
            pg8::gemm_phase<EpiOut, pg8::StaticOrder, true, true>(lds, g, S, E);
            if (l + 1 < DEPTH && G > 16 && bx >= 16) { LAUNDER(); convert_layer(p, l + 1, lds, (bx - 16) * 8 + wave_, (G - 16) * 8, wave_, lane_); }
            else if (l + 1 < DEPTH && G <= 16) { LAUNDER(); convert_layer(p, l + 1, lds, bx * 8 + wave_, G * 8, wave_, lane_); }
        }
#endif
        GSYNC();
#ifndef NO_P4
        { LAUNDER(); ln_phase(p, l, wave_, lane_); }
#endif
        if (l < DEPTH - 1) GSYNC();
    }
}

extern "C" void kernel_launch(void* const* d_in, const int* in_sizes, int n_in, void* d_out, int out_size, void* d_ws, size_t ws_size, hipStream_t stream) {
    static int grid_blocks = 0;
    if (grid_blocks == 0) {
        if (ws_size < WS_END) { fprintf(stderr, "kernel_launch: workspace too small: %zu < %zu\n", ws_size, (size_t)WS_END); grid_blocks = -1; return; }
        int dev = 0, cus = 0, per_cu = 0;
        hipGetDevice(&dev);
        hipDeviceGetAttribute(&cus, hipDeviceAttributeMultiprocessorCount, dev);
        if (hipFuncSetAttribute((const void*)fwd_megakernel, hipFuncAttributeMaxDynamicSharedMemorySize, LDS_BYTES) != hipSuccess) { fprintf(stderr, "kernel_launch: hipFuncSetAttribute failed\n"); }
        if (hipOccupancyMaxActiveBlocksPerMultiprocessor(&per_cu, (const void*)fwd_megakernel, 512, LDS_BYTES) != hipSuccess || per_cu < 1) { fprintf(stderr, "kernel_launch: occupancy query gave %d\n", per_cu); per_cu = 1; }
        (void)hipGetLastError();
        if (per_cu > 1) per_cu = 1;
        grid_blocks = cus * per_cu;
    }
    if (grid_blocks < 0) return;
    Params p{};
    p.x = (const float*)d_in[0]; p.meta = (const float*)d_in[1]; p.w_in = (const float*)d_in[2]; p.conv_w = (const float*)d_in[3]; p.conv_b = (const float*)d_in[4];
    p.conv_ln_g = (const float*)d_in[5]; p.conv_ln_b = (const float*)d_in[6]; p.w_out = (const float*)d_in[7]; p.post_g = (const float*)d_in[8]; p.post_b = (const float*)d_in[9];
    p.out = (float*)d_out; p.ws = (unsigned char*)d_ws;
    void* args[] = {&p};
    if (hipMemsetAsync((char*)d_ws + WS_BAR, 0, 16384, stream) != hipSuccess) { fprintf(stderr, "kernel_launch: hipMemsetAsync of the barrier words failed\n"); return; }
    hipError_t e = hipLaunchCooperativeKernel((const void*)fwd_megakernel, dim3(grid_blocks), dim3(512), args, LDS_BYTES, stream);
    if (e != hipSuccess) fprintf(stderr, "cooperative launch failed: %s (grid %d)\n", hipGetErrorString(e), grid_blocks);
}
```

```cpp
#include <hip/hip_runtime.h>
#include <hip/hip_cooperative_groups.h>
#include <cstdio>
#include <cstdint>
namespace cg = cooperative_groups;
namespace pg8 {
#define PG8_LAS __attribute__((address_space(3)))
typedef unsigned short bf16_t;
typedef short bf16x8 __attribute__((ext_vector_type(8)));
typedef float f32x4 __attribute__((ext_vector_type(4)));
typedef unsigned u32x4 __attribute__((ext_vector_type(4)));
constexpr int BM = 256, BK = 64, HALF = 128, HTB = HALF * BK * 2  , STAGE_BYTES = 8 * HTB, NXCD = 8, WGM = 8;

__host__ __device__ __forceinline__ int lds_byte(int r, int c) { const int st = (r >> 4) * 2 + (c >> 5), rr = r & 15, cc = c & 31, ob = rr * 64 + cc * 2; return st * 1024 + (ob ^ (((ob >> 9) & 1) << 5)); }
__host__ __device__ __forceinline__ void stage_rc(int b, int& R, int& C) { const int st = b / 1024, sb = b % 1024, swz = sb ^ (((sb >> 9) & 1) << 5); R = (st >> 1) * 16 + swz / 64; C = (st & 1) * 32 + (swz % 64) / 2; }
__host__ __device__ __forceinline__ int perm32(int rho) { const int n = rho >> 4, i = rho & 15; return 8 * (i >> 2) + 4 * n + (i & 3); }

struct Unit { int pm, pn; };
struct Gemm { const bf16_t* A; const bf16_t* Bt; int M, N, K; };

struct StaticOrder {
    int nM, nN, nwg, G, c;
    __host__ __device__ void init(int M, int N, int G_, int c_) { nM = M / BM; nN = N / BM; nwg = nM * nN; G = G_; c = c_; }
    __host__ __device__ bool next(int i, Unit& u) const {
        const long L = (long)i * G + c; if (L >= nwg) return false;
        int wgid = (int)L; { const int q = nwg / NXCD, r = nwg % NXCD, xcd = wgid % NXCD, off = wgid / NXCD; wgid = (xcd < r ? xcd * (q + 1) : r * (q + 1) + (xcd - r) * q) + off; }
        const int nig = WGM * nN, gid = wgid / nig, fm = gid * WGM, gsz = (nM - fm) < WGM ? (nM - fm) : WGM;
        u.pm = fm + ((wgid % nig) % gsz); u.pn = (wgid % nig) / gsz; return true;
    }
    __device__ __forceinline__ void a_ready(const Unit&) const {}
    __device__ __forceinline__ void done(const Unit&) const {}
};
template <class Epi, class Sched, bool ALIGN_EPI = false, bool SP2 = false>
__device__ __forceinline__ void gemm_phase(PG8_LAS unsigned char* lds, const Gemm g, const Sched& S, const Epi& E) {
    int tid = threadIdx.x; asm volatile("" : "+v"(tid)); const int wid = __builtin_amdgcn_readfirstlane(tid >> 6), lane = tid & 63, wr = wid >> 2, wc = wid & 3, fr = lane & 15, fq = lane >> 4;
    const int K = g.K, nt = K / BK;
    unsigned voffA[2], voffB[2];
#pragma unroll
    for (int i = 0; i < 2; ++i) { int R, C; stage_rc(tid * 16 + i * 8192, R, C); const int Rb = Epi::PERM ? ((R & ~31) + perm32(R & 31)) : R;
        voffA[i] = (unsigned)(R * K + C) * 2u; voffB[i] = (unsigned)(Rb * K + C) * 2u; }
    const size_t kstep = (size_t)(BK * 2);
    const size_t hstep = (size_t)HALF * K * 2;
    const size_t tstep = 2 * hstep;
    const unsigned ldsw = (unsigned)wid * 1024u;
    const int aoff = lds_byte(wr * 64 + fr, fq * 8), boff = lds_byte(wc * 32 + fr, fq * 8);
#define PG8_SA(b, h) (((b) * 2 + (h)) * HTB)
#define PG8_SB(b, h) ((4 + (b) * 2 + (h)) * HTB)
#define PG8_STAGE(bufoff, gbase, voff) do { _Pragma("unroll") for (int _i = 0; _i < 2; ++_i) \
        __builtin_amdgcn_global_load_lds((const unsigned*)((const char*)(gbase) + (voff)[_i]), (PG8_LAS unsigned*)(lds + (bufoff) + ldsw + _i * 8192), 16, 0, 0); } while (0)
#define PG8_LDA(dst, b, h) do { _Pragma("unroll") for (int m = 0; m < 4; ++m) _Pragma("unroll") for (int k = 0; k < 2; ++k) dst[m][k] = *(const PG8_LAS bf16x8*)(lds + PG8_SA(b, h) + aoff + m * 2048 + k * 1024); } while (0)
#define PG8_LDB(dst, b, h) do { _Pragma("unroll") for (int n = 0; n < 2; ++n) _Pragma("unroll") for (int k = 0; k < 2; ++k) dst[n][k] = *(const PG8_LAS bf16x8*)(lds + PG8_SB(b, h) + boff + n * 2048 + k * 1024); } while (0)
#define PG8_MMA(ai, bj, At, Bt) do { __builtin_amdgcn_s_setprio(1); _Pragma("unroll") for (int m = 0; m < 4; ++m) _Pragma("unroll") for (int n = 0; n < 2; ++n) _Pragma("unroll") for (int k = 0; k < 2; ++k) \
        acc[ai][bj][m][n] = __builtin_amdgcn_mfma_f32_16x16x32_bf16(Bt[n][k], At[m][k], acc[ai][bj][m][n], 0, 0, 0); __builtin_amdgcn_s_setprio(0); } while (0)
#define PG8_WAIT_V(n) asm volatile("s_waitcnt vmcnt(" #n ")" ::: "memory")
#define PG8_WAIT_L(n) asm volatile("s_waitcnt lgkmcnt(" #n ")" ::: "memory")
#define PG8_BAR __builtin_amdgcn_s_barrier()
#define PG8_SCHED __builtin_amdgcn_sched_barrier(0)
    Unit cur, nxt; int ui = 0;
    if (!S.next(0, cur)) return;
    f32x4 acc[2][2][4][2];
#pragma unroll
    for (int a = 0; a < 2; ++a)
#pragma unroll
        for (int b = 0; b < 2; ++b)
#pragma unroll
            for (int m = 0; m < 4; ++m)
#pragma unroll
                for (int n = 0; n < 2; ++n) acc[a][b][m][n] = (f32x4){0.f, 0.f, 0.f, 0.f};
    bf16x8 At[4][2], B0[2][2], B1[2][2];
    const char* cA = (const char*)g.A + (size_t)cur.pm * tstep; const char* cB = (const char*)g.Bt + (size_t)cur.pn * tstep;
    S.a_ready(cur);
    if constexpr (SP2) {
        PG8_STAGE(PG8_SB(0, 0), cB, voffB); PG8_STAGE(PG8_SB(0, 1), cB + hstep, voffB); PG8_STAGE(PG8_SA(0, 0), cA, voffA); PG8_STAGE(PG8_SA(0, 1), cA + hstep, voffA);
        if (wr == 1) PG8_BAR;
        PG8_WAIT_V(2); PG8_BAR;
        PG8_STAGE(PG8_SB(1, 0), cB + kstep, voffB); PG8_STAGE(PG8_SA(1, 0), cA + kstep, voffA); PG8_STAGE(PG8_SB(1, 1), cB + hstep + kstep, voffB);
        PG8_WAIT_V(6); PG8_BAR;
    } else {
        PG8_STAGE(PG8_SB(0, 0), cB, voffB); PG8_STAGE(PG8_SA(0, 0), cA, voffA); PG8_STAGE(PG8_SB(0, 1), cB + hstep, voffB); PG8_STAGE(PG8_SA(0, 1), cA + hstep, voffA);
        if (wr == 1) PG8_BAR;
        PG8_WAIT_V(4); PG8_BAR;
        PG8_STAGE(PG8_SB(1, 0), cB + kstep, voffB); PG8_STAGE(PG8_SA(1, 0), cA + kstep, voffA); PG8_STAGE(PG8_SB(1, 1), cB + hstep + kstep, voffB);
        PG8_WAIT_V(6); PG8_BAR;
    }
    for (;;) {
        const bool has_next = S.next(ui + 1, nxt);
        const char* nA = has_next ? (const char*)g.A + (size_t)nxt.pm * tstep : cA; const char* nB = has_next ? (const char*)g.Bt + (size_t)nxt.pn * tstep : cB;
        for (int t = 0; t < nt; t += 2) {
            const bool last = (t == nt - 2);
            const char* a1 = cA + (size_t)(t + 1) * kstep;
            const char* a2 = last ? nA : cA + (size_t)(t + 2) * kstep; const char* b2 = last ? nB : cB + (size_t)(t + 2) * kstep;
            const char* a3 = a2 + kstep; const char* b3 = b2 + kstep;
            if (last && has_next) S.a_ready(nxt);
            if constexpr (SP2) {
            PG8_LDB(B0, 0, 0); PG8_LDB(B1, 0, 1); PG8_SCHED; PG8_LDA(At, 0, 0); PG8_STAGE(PG8_SA(1, 1), a1 + hstep, voffA);
            PG8_WAIT_V(8); PG8_WAIT_L(0); PG8_BAR; PG8_MMA(0, 0, At, B0); PG8_MMA(0, 1, At, B1); PG8_BAR; PG8_SCHED;
            PG8_LDA(At, 0, 1); PG8_STAGE(PG8_SB(0, 0), b2, voffB); PG8_STAGE(PG8_SB(0, 1), b2 + hstep, voffB); PG8_STAGE(PG8_SA(0, 0), a2, voffA);
            PG8_WAIT_V(8); PG8_WAIT_L(0); PG8_BAR; PG8_MMA(1, 0, At, B0); PG8_MMA(1, 1, At, B1); PG8_BAR; PG8_SCHED;
            PG8_LDB(B0, 1, 0); PG8_LDB(B1, 1, 1); PG8_SCHED; PG8_LDA(At, 1, 0); PG8_STAGE(PG8_SA(0, 1), a2 + hstep, voffA);
            PG8_WAIT_V(8); PG8_WAIT_L(0); PG8_BAR; PG8_MMA(0, 0, At, B0); PG8_MMA(0, 1, At, B1); PG8_BAR; PG8_SCHED;
            PG8_LDA(At, 1, 1); PG8_STAGE(PG8_SB(1, 0), b3, voffB); PG8_STAGE(PG8_SB(1, 1), b3 + hstep, voffB); PG8_STAGE(PG8_SA(1, 0), a3, voffA);
            PG8_WAIT_V(8); PG8_WAIT_L(0); PG8_BAR; PG8_MMA(1, 0, At, B0); PG8_MMA(1, 1, At, B1); PG8_BAR; PG8_SCHED;
            } else {
            PG8_LDB(B0, 0, 0); PG8_SCHED; PG8_LDA(At, 0, 0); PG8_STAGE(PG8_SA(1, 1), a1 + hstep, voffA);
            PG8_WAIT_L(8); PG8_BAR; PG8_WAIT_L(0); PG8_MMA(0, 0, At, B0); PG8_BAR; PG8_SCHED;
            PG8_LDB(B1, 0, 1); PG8_STAGE(PG8_SB(0, 0), b2, voffB);
            PG8_BAR; PG8_WAIT_L(0); PG8_MMA(0, 1, At, B1); PG8_BAR;
            PG8_LDA(At, 0, 1); PG8_STAGE(PG8_SA(0, 0), a2, voffA);
            PG8_BAR; PG8_WAIT_L(0); PG8_MMA(1, 0, At, B0); PG8_BAR; PG8_SCHED;
            PG8_STAGE(PG8_SB(0, 1), b2 + hstep, voffB);
            PG8_WAIT_V(6); PG8_BAR; PG8_MMA(1, 1, At, B1); PG8_BAR;
            PG8_LDB(B0, 1, 0); PG8_SCHED; PG8_LDA(At, 1, 0); PG8_STAGE(PG8_SA(0, 1), a2 + hstep, voffA);
            PG8_WAIT_L(8); PG8_BAR; PG8_WAIT_L(0); PG8_MMA(0, 0, At, B0); PG8_BAR; PG8_SCHED;
            PG8_LDB(B1, 1, 1); PG8_STAGE(PG8_SB(1, 0), b3, voffB);
            PG8_BAR; PG8_WAIT_L(0); PG8_MMA(0, 1, At, B1); PG8_BAR;
            PG8_LDA(At, 1, 1); PG8_STAGE(PG8_SA(1, 0), a3, voffA);
            PG8_BAR; PG8_WAIT_L(0); PG8_MMA(1, 0, At, B0); PG8_BAR; PG8_SCHED;
            PG8_STAGE(PG8_SB(1, 1), b3 + hstep, voffB);
            PG8_WAIT_V(6); PG8_BAR; PG8_MMA(1, 1, At, B1); PG8_BAR;
            }
        }
        if constexpr (ALIGN_EPI) { if (wr == 0) PG8_BAR; }
        if constexpr (!Epi::AFTER_DRAIN) { E(acc, cur, wr, wc, fr, fq); S.done(cur); }
        if (!has_next) break;
#pragma unroll
        for (int a = 0; a < 2; ++a)
#pragma unroll
            for (int b = 0; b < 2; ++b)
#pragma unroll
                for (int m = 0; m < 4; ++m)
#pragma unroll
                    for (int n = 0; n < 2; ++n) acc[a][b][m][n] = (f32x4){0.f, 0.f, 0.f, 0.f};
        cur = nxt; cA = nA; cB = nB; ++ui;
        if constexpr (ALIGN_EPI) { if (wr == 1) PG8_BAR; }
    }
    PG8_WAIT_V(0);
    if constexpr (!ALIGN_EPI) { if (wr == 0) PG8_BAR; }
    PG8_BAR;
    if constexpr (Epi::AFTER_DRAIN) { E.fused(acc, cur, wr, wc, fr, fq, lds, wid, lane); S.done(cur); }
#undef PG8_SA
#undef PG8_SB
#undef PG8_STAGE
#undef PG8_LDA
#undef PG8_LDB
#undef PG8_MMA
#undef PG8_WAIT_V
#undef PG8_WAIT_L
#undef PG8_BAR
#undef PG8_SCHED
}
}

#define LAS __attribute__((address_space(3)))
typedef unsigned short bf16_t;
typedef short bf16x8 __attribute__((ext_vector_type(8)));
typedef short s16x4 __attribute__((ext_vector_type(4)));
typedef float f32x4 __attribute__((ext_vector_type(4)));
typedef float f32x2 __attribute__((ext_vector_type(2)));
typedef float f32x16 __attribute__((ext_vector_type(16)));
typedef unsigned u32x4 __attribute__((ext_vector_type(4)));
typedef unsigned u32x2 __attribute__((ext_vector_type(2)));
typedef __bf16 bf16x2_t __attribute__((ext_vector_type(2)));

constexpr int NB = 8, SEQ = 4096, DM = 1024, DEPTH = 4, NMETA = 16;
constexpr int LV = SEQ + NMETA;
constexpr int LP = 4224;
constexpr int NR = NB * LP;
constexpr int DIN = 4168, NPAD = 4352;
constexpr int BW = 132;
constexpr float LN_EPS = 1e-5f;
constexpr float DN_ALPHA = 1.681792830507429f;
constexpr float QSCALE = 0.125f * 1.4426950408889634f;
constexpr float IDX_W_SCALE = 0.35355339059327373f;
constexpr int SSTR = 4232;
constexpr int LDS_BYTES = 157696;

constexpr size_t al256(size_t x) { return (x + 255) & ~(size_t)255; }
constexpr size_t WS_BAR = 0;
constexpr size_t WS_COS = 16384;
constexpr size_t WS_SIN = WS_COS + al256((size_t)LP * 32 * 4);
constexpr size_t WS_WIN = WS_SIN + al256((size_t)LP * 32 * 4);
constexpr size_t WS_WOUT = WS_WIN + (size_t)DEPTH * NPAD * 1024 * 2;
constexpr size_t WS_HB = WS_WOUT + (size_t)DEPTH * 1024 * 1024 * 2;
constexpr size_t SZ512 = (size_t)NR * 512 * 2;
constexpr size_t WS_U = WS_HB + (size_t)NR * 1024 * 2;
constexpr size_t WS_ZC = WS_U + SZ512;
constexpr size_t WS_Q = WS_ZC + SZ512;
constexpr size_t WS_K = WS_Q + SZ512;
constexpr size_t WS_V = WS_K + SZ512;
constexpr size_t WS_ZA = WS_V + SZ512;
constexpr size_t WS_QI = WS_ZA + SZ512;
constexpr size_t WS_KI = WS_QI + SZ512;
constexpr size_t WS_WI = WS_KI + (size_t)NR * 64 * 2;
constexpr size_t WS_YMIX = WS_WI + (size_t)NR * 8 * 4;
constexpr size_t WS_BITS = WS_YMIX + (size_t)NR * 1024 * 2;
constexpr size_t WS_METAH = WS_BITS + (size_t)NR * BW * 4;
constexpr size_t WS_STAT = WS_METAH + (size_t)NB * NMETA * 1024 * 4;
constexpr size_t WS_DUMP = WS_STAT + (size_t)NR * 2 * 4;
constexpr size_t WS_END = WS_DUMP + 4096;

struct Params {
    const float* x; const float* meta; const float* w_in; const float* conv_w; const float* conv_b;
    const float* conv_ln_g; const float* conv_ln_b; const float* w_out; const float* post_g; const float* post_b;
    float* out; unsigned char* ws;
};

__device__ __forceinline__ unsigned pk2(float lo, float hi) { f32x2 v = {lo, hi}; bf16x2_t b = __builtin_convertvector(v, bf16x2_t); return __builtin_bit_cast(unsigned, b); }
__device__ __forceinline__ float bflo(unsigned w) { return __uint_as_float(w << 16); }
__device__ __forceinline__ float bfhi(unsigned w) { return __uint_as_float(w & 0xffff0000u); }
__device__ __forceinline__ float sigmoidf_(float x) { return __builtin_amdgcn_rcpf(1.0f + __expf(-x)); }
__device__ __forceinline__ float wave_sum(float v) {
#pragma unroll
    for (int o = 1; o < 64; o <<= 1) v += __shfl_xor(v, o);
    return v;
}

__device__ __forceinline__ int in_colmap(int c) {
    const int pn = c >> 8, w = c & 255;
    if (pn < 4) return (w < 128) ? (128 * pn + w) : (512 + 128 * pn + (w - 128));
    if (pn == 16) { if (w < 64) return 4096 + (w >> 1) + 32 * (w & 1); if (w < 72) return 4160 + (w - 64); return -1; }
    const int kind = (pn - 4) >> 1;
    const int base = 1024 + 512 * kind + 256 * (pn & 1);
    if (kind == 1 || kind == 2 || kind == 5) return base + 64 * (w >> 6) + ((w & 63) >> 1) + 32 * (w & 1);
    return base + w;
}

struct EpiIn {
    static constexpr bool PERM = true, AFTER_DRAIN = false;
    bf16_t *U, *ZC, *Q, *K, *V, *ZA, *QI, *KI; float* WI; const float* cosT; const float* sinT;
    __device__ __forceinline__ void operator()(const pg8::f32x4 (&acc)[2][2][4][2], const pg8::Unit& u, int wr, int wc, int fr, int fq) const {
        const int pn = u.pn;
        const int row0 = u.pm * 256 + wr * 64 + fr;
        const int w0 = wc * 32 + 8 * fq;
        if (pn < 4) {
#pragma unroll
            for (int ai = 0; ai < 2; ++ai)
#pragma unroll
                for (int m = 0; m < 4; ++m) {
                    const int r = row0 + ai * 128 + m * 16;
                    const pg8::f32x4 a0 = acc[ai][0][m][0], a1 = acc[ai][0][m][1], g0 = acc[ai][1][m][0], g1 = acc[ai][1][m][1];
                    u32x4 w;
                    w.x = pk2(a0[0] * sigmoidf_(g0[0]), a0[1] * sigmoidf_(g0[1])); w.y = pk2(a0[2] * sigmoidf_(g0[2]), a0[3] * sigmoidf_(g0[3]));
                    w.z = pk2(a1[0] * sigmoidf_(g1[0]), a1[1] * sigmoidf_(g1[1])); w.w = pk2(a1[2] * sigmoidf_(g1[2]), a1[3] * sigmoidf_(g1[3]));
                    *(u32x4*)(U + (size_t)r * 512 + pn * 128 + w0) = w;
                }
        } else if (pn == 16) {
            if (w0 < 64) {
                const int i0 = w0 >> 1;
#pragma unroll
                for (int ai = 0; ai < 2; ++ai)
#pragma unroll
                    for (int m = 0; m < 4; ++m) {
                        const int r = row0 + ai * 128 + m * 16; const int t = r % LP;
                        const f32x4 c4 = *(const f32x4*)(cosT + t * 32 + i0), s4 = *(const f32x4*)(sinT + t * 32 + i0);
                        const pg8::f32x4 v0 = acc[ai][0][m][0], v1 = acc[ai][0][m][1];
                        u32x4 w;
                        w.x = pk2(v0[0] * c4[0] - v0[1] * s4[0], v0[1] * c4[0] + v0[0] * s4[0]);
                        w.y = pk2(v0[2] * c4[1] - v0[3] * s4[1], v0[3] * c4[1] + v0[2] * s4[1]);
                        w.z = pk2(v1[0] * c4[2] - v1[1] * s4[2], v1[1] * c4[2] + v1[0] * s4[2]);
                        w.w = pk2(v1[2] * c4[3] - v1[3] * s4[3], v1[3] * c4[3] + v1[2] * s4[3]);
                        *(u32x4*)(KI + (size_t)r * 64 + w0) = w;
                    }
            } else if (w0 == 64) {
#pragma unroll
                for (int ai = 0; ai < 2; ++ai)
#pragma unroll
                    for (int m = 0; m < 4; ++m) {
                        const int r = row0 + ai * 128 + m * 16;
                        *(f32x4*)(WI + (size_t)r * 8) = acc[ai][0][m][0] * IDX_W_SCALE;
                        *(f32x4*)(WI + (size_t)r * 8 + 4) = acc[ai][0][m][1] * IDX_W_SCALE;
                    }
            }
        } else {
            const int kind = (pn - 4) >> 1;
            bf16_t* base = kind == 0 ? ZC : kind == 1 ? Q : kind == 2 ? K : kind == 3 ? V : kind == 4 ? ZA : QI;
            const int cb = (pn & 1) * 256 + w0;
            if (kind == 0 || kind == 4) {
#pragma unroll
                for (int ai = 0; ai < 2; ++ai)
#pragma unroll
                    for (int m = 0; m < 4; ++m) {
                        const int r = row0 + ai * 128 + m * 16;
#pragma unroll
                        for (int bj = 0; bj < 2; ++bj) {
                            const pg8::f32x4 v0 = acc[ai][bj][m][0], v1 = acc[ai][bj][m][1];
                            u32x4 w;
                            w.x = pk2(v0[0] * sigmoidf_(v0[0]), v0[1] * sigmoidf_(v0[1])); w.y = pk2(v0[2] * sigmoidf_(v0[2]), v0[3] * sigmoidf_(v0[3]));
                            w.z = pk2(v1[0] * sigmoidf_(v1[0]), v1[1] * sigmoidf_(v1[1])); w.w = pk2(v1[2] * sigmoidf_(v1[2]), v1[3] * sigmoidf_(v1[3]));
                            *(u32x4*)(base + (size_t)r * 512 + cb + bj * 128) = w;
                        }
                    }
            } else if (kind == 3) {
#pragma unroll
                for (int ai = 0; ai < 2; ++ai)
#pragma unroll
                    for (int m = 0; m < 4; ++m) {
                        const int r = row0 + ai * 128 + m * 16;
#pragma unroll
                        for (int bj = 0; bj < 2; ++bj) {
                            const pg8::f32x4 v0 = acc[ai][bj][m][0], v1 = acc[ai][bj][m][1];
                            u32x4 w; w.x = pk2(v0[0], v0[1]); w.y = pk2(v0[2], v0[3]); w.z = pk2(v1[0], v1[1]); w.w = pk2(v1[2], v1[3]);
                            *(u32x4*)(base + (size_t)r * 512 + cb + bj * 128) = w;
                        }
                    }
            } else {
                const float sc = kind == 1 ? QSCALE : kind == 5 ? 0.125f : 1.0f;
                const int i0 = (w0 & 63) >> 1;
                f32x4 cN = *(const f32x4*)(cosT + (row0 % LP) * 32 + i0), sN = *(const f32x4*)(sinT + (row0 % LP) * 32 + i0);
#pragma unroll
                for (int g8 = 0; g8 < 8; ++g8) {
                    const int ai = g8 >> 2, m = g8 & 3;
                    const int r = row0 + ai * 128 + m * 16;
                    const f32x4 c4 = cN * sc, s4 = sN * sc;
                    if (g8 < 7) { const int rn = row0 + ((g8 + 1) >> 2) * 128 + ((g8 + 1) & 3) * 16; const int tn = rn % LP; cN = *(const f32x4*)(cosT + tn * 32 + i0); sN = *(const f32x4*)(sinT + tn * 32 + i0); }
#pragma unroll
                    for (int bj = 0; bj < 2; ++bj) {
                        const pg8::f32x4 v0 = acc[ai][bj][m][0], v1 = acc[ai][bj][m][1];
                        u32x4 w;
                        w.x = pk2(v0[0] * c4[0] - v0[1] * s4[0], v0[1] * c4[0] + v0[0] * s4[0]);
                        w.y = pk2(v0[2] * c4[1] - v0[3] * s4[1], v0[3] * c4[1] + v0[2] * s4[1]);
                        w.z = pk2(v1[0] * c4[2] - v1[1] * s4[2], v1[1] * c4[2] + v1[0] * s4[2]);
                        w.w = pk2(v1[2] * c4[3] - v1[3] * s4[3], v1[3] * c4[3] + v1[2] * s4[3]);
                        *(u32x4*)(base + (size_t)r * 512 + cb + bj * 128) = w;
                    }
                }
            }
        }
    }
};

struct EpiOut {
    static constexpr bool PERM = false, AFTER_DRAIN = false;
    const float* src_main; const float* src_meta; int src_meta_bstride; float* dst_main; float* dst_meta;
    const float* stat; const float* pg; const float* pb;
    float* dump;
    __device__ __forceinline__ void rowp(int r, const float*& sp, float*& dp) const {
        const int b = r / LP, t = r - b * LP;
        if (t < NMETA) { sp = src_meta + (size_t)b * src_meta_bstride + t * 1024; dp = dst_meta + (size_t)(b * NMETA + t) * 1024; }
        else { const int tt = t < LV ? t : NMETA; const size_t o = ((size_t)b * SEQ + (tt - NMETA)) * 1024; sp = src_main + o; dp = (t < LV) ? (dst_main + o) : dump; }
    }
    __device__ __forceinline__ void operator()(const pg8::f32x4 (&acc)[2][2][4][2], const pg8::Unit& u, int wr, int wc, int fr, int fq) const {
        const int col0 = u.pn * 256 + wc * 32 + 4 * fq;
        const int row0 = u.pm * 256 + wr * 64 + fr;
        const bool rebuild = stat != nullptr;
        f32x4 g4[2][2], b4[2][2];
#pragma unroll
        for (int bj = 0; bj < 2; ++bj)
#pragma unroll
            for (int n = 0; n < 2; ++n) { g4[bj][n] = (f32x4){1.f, 1.f, 1.f, 1.f}; b4[bj][n] = (f32x4){0.f, 0.f, 0.f, 0.f};
                if (rebuild) { g4[bj][n] = *(const f32x4*)(pg + col0 + bj * 128 + n * 16); b4[bj][n] = *(const f32x4*)(pb + col0 + bj * 128 + n * 16); } }
        const float* spn; float* dpn; rowp(row0, spn, dpn);
        f32x4 hvn[2][2]; f32x2 stn = {0.f, 1.f};
#pragma unroll
        for (int bj = 0; bj < 2; ++bj)
#pragma unroll
            for (int n = 0; n < 2; ++n) hvn[bj][n] = *(const f32x4*)(spn + col0 + bj * 128 + n * 16);
        if (rebuild) stn = *(const f32x2*)(stat + (size_t)row0 * 2);
#pragma unroll
        for (int g8 = 0; g8 < 8; ++g8) {
            const int ai = g8 >> 2, m = g8 & 3;
            f32x4 hv[2][2]; const f32x2 st = stn; float* dp = dpn;
#pragma unroll
            for (int bj = 0; bj < 2; ++bj)
#pragma unroll
                for (int n = 0; n < 2; ++n) hv[bj][n] = hvn[bj][n];
            if (g8 < 7) {
                const int rn = row0 + ((g8 + 1) >> 2) * 128 + ((g8 + 1) & 3) * 16; rowp(rn, spn, dpn);
#pragma unroll
                for (int bj = 0; bj < 2; ++bj)
#pragma unroll
                    for (int n = 0; n < 2; ++n) hvn[bj][n] = *(const f32x4*)(spn + col0 + bj * 128 + n * 16);
                if (rebuild) stn = *(const f32x2*)(stat + (size_t)rn * 2);
            }
#pragma unroll
            for (int bj = 0; bj < 2; ++bj)
#pragma unroll
                for (int n = 0; n < 2; ++n) {
                    f32x4 h = hv[bj][n];
                    if (rebuild) h = (h - st[0]) * st[1] * g4[bj][n] + b4[bj][n];
                    *(f32x4*)(dp + col0 + bj * 128 + n * 16) = h * DN_ALPHA + acc[ai][bj][m][n];
                }
        }
    }
};

template <bool MAPPED>
__device__ __forceinline__ void p0_transpose_item(const float* W, int N, bf16_t* WT, LAS float* scr, int kb, int nb, int lane) {
    const int k0 = 64 * kb, n0 = 32 * nb;
    const int col = MAPPED ? in_colmap(n0 + (lane & 31)) : (n0 + (lane & 31));
    float wreg[32];
#pragma unroll
    for (int i = 0; i < 32; ++i) { const int kk = 2 * i + (lane >> 5); wreg[i] = (col >= 0) ? W[(size_t)(k0 + kk) * N + col] : 0.f; }
#pragma unroll
    for (int i = 0; i < 32; ++i) { const int kk = 2 * i + (lane >> 5); scr[kk * 33 + (lane & 31)] = wreg[i]; }
    asm volatile("s_waitcnt lgkmcnt(0)" ::: "memory");
    const int c = lane & 7;
#pragma unroll
    for (int j = 0; j < 4; ++j) { const int n = (lane >> 3) + 8 * j; const LAS float* s = scr + (8 * c) * 33 + n;
        u32x4 o; o.x = pk2(s[0 * 33], s[1 * 33]); o.y = pk2(s[2 * 33], s[3 * 33]); o.z = pk2(s[4 * 33], s[5 * 33]); o.w = pk2(s[6 * 33], s[7 * 33]);
        *(u32x4*)(WT + (size_t)(n0 + n) * 1024 + k0 + 8 * c) = o; }
    asm volatile("s_waitcnt lgkmcnt(0)" ::: "memory");
}

__device__ __forceinline__ void convert_layer(const Params& p, int l, LAS unsigned char* lds, int iw, int nw, int wave, int lane) {
    unsigned char* ws = p.ws;
    LAS float* scr = (LAS float*)(lds + wave * 8704);
    constexpr int IT_IN = 16 * (NPAD / 32), IT_OUT = 16 * 32, IT_L = IT_IN + IT_OUT;
    for (int it = iw; it < IT_L; it += nw) {
        int r = it;
        if (r < IT_IN) { const int kb = r / (NPAD / 32), nb = r - kb * (NPAD / 32);
            p0_transpose_item<true>(p.w_in + (size_t)l * 1024 * DIN, DIN, (bf16_t*)(ws + WS_WIN) + (size_t)l * NPAD * 1024, scr, kb, nb, lane); }
        else { r -= IT_IN; const int kb = r / 32, nb = r - kb * 32;
            p0_transpose_item<false>(p.w_out + (size_t)l * 1024 * 1024, 1024, (bf16_t*)(ws + WS_WOUT) + (size_t)l * 1024 * 1024, scr, kb, nb, lane); }
    }
}
__device__ __forceinline__ void p0_prologue(const Params& p, LAS unsigned char* lds, int wave, int lane) {
    unsigned char* ws = p.ws;
    LAS float* scr = (LAS float*)(lds + wave * 8704);
    const int gw = blockIdx.x * 8 + wave, NGW = gridDim.x * 8;
    (void)scr;
    convert_layer(p, 0, lds, gw, NGW, wave, lane);
    bf16_t* HB = (bf16_t*)(ws + WS_HB);
    for (int r0 = gw; r0 < NR; r0 += 4 * NGW) {
        f32x4 va[4][4]; bool live[4]; int rr[4];
#pragma unroll
        for (int k = 0; k < 4; ++k) {
            const int r = r0 + k * NGW; rr[k] = r; live[k] = false;
            const int rc = r < NR ? r : r0; const int b = rc / LP, t = rc - b * LP;
            const float* src = (t < NMETA) ? (p.meta + (size_t)t * 1024) : (p.x + ((size_t)b * SEQ + ((t < LV ? t : NMETA) - NMETA)) * 1024);
            live[k] = (r < NR) && (t < LV);
#pragma unroll
            for (int j = 0; j < 4; ++j) va[k][j] = *((const f32x4*)src + lane + 64 * j);
        }
#pragma unroll
        for (int k = 0; k < 4; ++k) {
            if (rr[k] < NR) {
                u32x2* o = (u32x2*)(HB + (size_t)rr[k] * 1024) + lane;
#pragma unroll
                for (int j = 0; j < 4; ++j) { u32x2 w; w.x = live[k] ? pk2(va[k][j][0], va[k][j][1]) : 0u; w.y = live[k] ? pk2(va[k][j][2], va[k][j][3]) : 0u; o[64 * j] = w; }
            }
        }
    }
    float* cosT = (float*)(ws + WS_COS); float* sinT = (float*)(ws + WS_SIN);
    for (int i = blockIdx.x * 512 + threadIdx.x; i < LP * 32; i += gridDim.x * 512) {
        const int t = i >> 5, f = i & 31;
        const float inv_freq = powf(10000.0f, -(float)(2 * f) / 64.0f);
        const float ang = (float)t * inv_freq;
        const double rev = (double)ang * 0.15915494309189535;
        const float fr = (float)(rev - floor(rev));
        cosT[i] = __builtin_amdgcn_cosf(fr); sinT[i] = __builtin_amdgcn_sinf(fr);
    }
}

#ifndef REP_SCORE
#define REP_SCORE 1
#endif
#ifndef REP_SEL
#define REP_SEL 1
#endif
constexpr int P2_HIST = 8 * SSTR * 4, P2_RS = P2_HIST + 8 * 512 * 4, P2_CAND = P2_RS + 64, P2_CIDX = P2_CAND + 8 * 64 * 4, P2_END = P2_CIDX + 8 * 64 * 4;
static_assert(P2_END <= LDS_BYTES, "P2 LDS map");
__device__ __forceinline__ int score_bin(float sc, float rs) { const float f = __builtin_amdgcn_fmed3f(__builtin_fmaf(sc, rs, 256.0f), 0.f, 511.f); return (int)f; }
__device__ __forceinline__ unsigned ord_key(float f) { const unsigned u = __float_as_uint(f); return (u & 0x80000000u) ? ~u : (u | 0x80000000u); }

__device__ __forceinline__ void select_bisect(const LAS float* Sr, unsigned long long* brow, int nj, int lane) {
    unsigned key[66];
#pragma unroll
    for (int j = 0; j < 66; ++j) { key[j] = 0u; if (j < nj) key[j] = ord_key(Sr[64 * j + lane]); }
    unsigned prefix = 0u; bool exact = false;
    for (int bit = 31; bit >= 0; --bit) {
        const unsigned cand = prefix | (1u << bit);
        int cnt = 0;
#pragma unroll
        for (int gq = 0; gq < 5; ++gq) if (gq * 16 < nj) {
#pragma unroll
            for (int jj = 0; jj < 16; ++jj) { const int j = gq * 16 + jj; if (j < 66) cnt += __popcll(__ballot(key[j] >= cand)); }
        }
        if (cnt >= 256) { prefix = cand; if (cnt == 256) { exact = true; break; } }
    }
    const unsigned thr = prefix;
    int need = 1 << 30;
    if (!exact) { int cgt = 0;
#pragma unroll
        for (int j = 0; j < 66; ++j) if (j < nj) cgt += __popcll(__ballot(key[j] > thr));
        need = 256 - cgt; }
    int eqb = 0;
#pragma unroll
    for (int j = 0; j < 66; ++j) if (j < nj) {
        const bool gt = key[j] > thr, eq = key[j] == thr;
        const unsigned long long em = __ballot(eq);
        const int rank = eqb + (int)__builtin_amdgcn_mbcnt_hi((unsigned)(em >> 32), __builtin_amdgcn_mbcnt_lo((unsigned)em, 0u));
        const bool sel = gt || (eq && rank < need);
        const unsigned long long sm = __ballot(sel);
        if (lane == 0) brow[j] = sm;
        eqb += __popcll(em);
    }
}

__device__ __forceinline__ void idx_item(int b, int g, const bf16_t* QI, const bf16_t* KI, const float* WI, unsigned* BITS, LAS unsigned char* lds, int tid, int wave, int lane) {
    LAS float* S = (LAS float*)lds; LAS unsigned* HIST = (LAS unsigned*)(lds + P2_HIST); LAS float* RS = (LAS float*)(lds + P2_RS);
    LAS unsigned* CAND = (LAS unsigned*)(lds + P2_CAND); LAS unsigned* CIDX = (LAS unsigned*)(lds + P2_CIDX);
    const int t0 = 8 * g; const int nj = t0 / 64 + 1; const int NT32 = 2 * nj;
    const int m = lane & 31, hh = lane >> 5;
    if (t0 + 7 >= 256) {
#pragma unroll
    for (int i = 0; i < 8; ++i) HIST[tid + 512 * i] = 0u;
    if (tid < 8) { const float* wp = WI + (size_t)(b * LP + t0 + tid) * 8; const f32x4 lo = *(const f32x4*)wp, hi = *(const f32x4*)(wp + 4);
        const float ss = (lo[0] * lo[0] + lo[1] * lo[1]) + (lo[2] * lo[2] + lo[3] * lo[3]) + (hi[0] * hi[0] + hi[1] * hi[1]) + (hi[2] * hi[2] + hi[3] * hi[3]);
        RS[tid] = 32.0f / sqrtf(0.5f * ss + 1e-20f); }
    {
        const int aq = 2 * ((m >> 2) & 1) + (m >> 4), ah = 4 * ((m >> 3) & 1) + (m & 3);
        bf16x8 af[2][4];
#pragma unroll
        for (int mb = 0; mb < 2; ++mb)
#pragma unroll
            for (int ks = 0; ks < 4; ++ks) af[mb][ks] = *(const bf16x8*)(QI + (size_t)(b * LP + t0 + 4 * mb + aq) * 512 + ah * 64 + ks * 16 + hh * 8);
        float wv[2][2][8];
#pragma unroll
        for (int mb = 0; mb < 2; ++mb)
#pragma unroll
            for (int qq = 0; qq < 2; ++qq) { const size_t row = (size_t)(b * LP + t0 + 4 * mb + 2 * hh + qq);
                const f32x4 lo = *(const f32x4*)(WI + row * 8), hi = *(const f32x4*)(WI + row * 8 + 4);
                wv[mb][qq][0] = lo[0]; wv[mb][qq][1] = lo[1]; wv[mb][qq][2] = lo[2]; wv[mb][qq][3] = lo[3];
                wv[mb][qq][4] = hi[0]; wv[mb][qq][5] = hi[1]; wv[mb][qq][6] = hi[2]; wv[mb][qq][7] = hi[3]; }
        const bf16_t* kbase = KI + (size_t)(b * LP + m) * 64 + hh * 8;
#define IDX_LOADB(dst, tile) do { _Pragma("unroll") for (int ks = 0; ks < 4; ++ks) dst[ks] = *(const bf16x8*)(kbase + (size_t)(32 * (tile)) * 64 + ks * 16); } while (0)
        bf16x8 kb0[4], kb1[4], kb2[4];
        for (int rsc_ = 0; rsc_ < REP_SCORE; ++rsc_) {
        const bool dh = (rsc_ == REP_SCORE - 1);
        int tl = wave;
        if (tl < NT32) IDX_LOADB(kb0, tl);
        if (tl + 8 < NT32) IDX_LOADB(kb1, tl + 8);
        if (tl + 16 < NT32) IDX_LOADB(kb2, tl + 16);
        __syncthreads();
        float rsv[2][2];
#pragma unroll
        for (int mb = 0; mb < 2; ++mb)
#pragma unroll
            for (int qq = 0; qq < 2; ++qq) rsv[mb][qq] = RS[4 * mb + 2 * hh + qq];
#define IDX_TILE(kb, tile) do { \
            const int s = 32 * (tile) + m; \
            f32x16 c0 = {}, c1 = {}; \
            _Pragma("unroll") for (int ks = 0; ks < 4; ++ks) { c0 = __builtin_amdgcn_mfma_f32_32x32x16_bf16(af[0][ks], kb[ks], c0, 0, 0, 0); c1 = __builtin_amdgcn_mfma_f32_32x32x16_bf16(af[1][ks], kb[ks], c1, 0, 0, 0); } \
            if ((tile) + 24 < NT32) IDX_LOADB(kb, (tile) + 24); \
            _Pragma("unroll") for (int qq = 0; qq < 2; ++qq) { \
                float s0 = 0.f, s1 = 0.f;     \
                _Pragma("unroll") for (int h = 0; h < 8; ++h) { s0 = fmaf(wv[0][qq][h], __builtin_amdgcn_fmed3f(c0[8 * qq + h], 0.f, 3.0e38f), s0); s1 = fmaf(wv[1][qq][h], __builtin_amdgcn_fmed3f(c1[8 * qq + h], 0.f, 3.0e38f), s1); } \
                const int q0 = 2 * hh + qq, q1 = 4 + 2 * hh + qq; \
                if (s <= t0 + q0) { if (dh) __hip_atomic_fetch_add(HIST + q0 * 512 + score_bin(s0, rsv[0][qq]), 1u, __ATOMIC_RELAXED, __HIP_MEMORY_SCOPE_WORKGROUP); } else s0 = -INFINITY; \
                if (s <= t0 + q1) { if (dh) __hip_atomic_fetch_add(HIST + q1 * 512 + score_bin(s1, rsv[1][qq]), 1u, __ATOMIC_RELAXED, __HIP_MEMORY_SCOPE_WORKGROUP); } else s1 = -INFINITY; \
                S[q0 * SSTR + s] = s0; S[q1 * SSTR + s] = s1; \
            } } while (0)
        for (; tl < NT32; tl += 24) {
            IDX_TILE(kb0, tl);
            if (tl + 8 < NT32) IDX_TILE(kb1, tl + 8);
            if (tl + 16 < NT32) IDX_TILE(kb2, tl + 16);
        }
        }
#undef IDX_TILE
#undef IDX_LOADB
    }
    __syncthreads();
    }
    for (int rse_ = 0; rse_ < REP_SEL; ++rse_) {
        const int t = t0 + wave;
        const LAS float* Sr = S + wave * SSTR;
        unsigned long long* brow = (unsigned long long*)(BITS + (size_t)(b * LP + t) * BW);
        if (t < 256) {
            for (int j = 0; j < nj; ++j) { const unsigned long long mk = __ballot((64 * j + lane) <= t); if (lane == 0) brow[j] = mk; }
        } else {
            const LAS unsigned* H = HIST + wave * 512;
            const u32x4 ha = *(const LAS u32x4*)(H + 8 * lane), hb = *(const LAS u32x4*)(H + 8 * lane + 4);
            const unsigned lsum = (ha.x + ha.y) + (ha.z + ha.w) + (hb.x + hb.y) + (hb.z + hb.w);
            unsigned incl = lsum;
#pragma unroll
            for (int o = 1; o < 64; o <<= 1) { const unsigned v = __shfl_down(incl, o); if (lane + o < 64) incl += v; }
            unsigned cum = incl - lsum; int Bsel = -1; unsigned cab = 0u;
#define P2_STEP(hv, i) do { if (Bsel < 0 && cum < 256u && cum + (hv) >= 256u) { Bsel = 8 * lane + (i); cab = cum; } cum += (hv); } while (0)
            P2_STEP(hb.w, 7); P2_STEP(hb.z, 6); P2_STEP(hb.y, 5); P2_STEP(hb.x, 4); P2_STEP(ha.w, 3); P2_STEP(ha.z, 2); P2_STEP(ha.y, 1); P2_STEP(ha.x, 0);
#undef P2_STEP
            const unsigned long long fm = __ballot(Bsel >= 0);
            const int src = (int)__ffsll((unsigned long long)fm) - 1;
            const int Bb = __builtin_amdgcn_readlane(Bsel, src);
            const int c_above = __builtin_amdgcn_readlane((int)cab, src);
            const int cB = (int)H[Bb];
            const int rr = 256 - c_above;
            if (fm == 0ull || cB > 64 || rr < 1 || rr > cB) {
                select_bisect(Sr, brow, nj, lane);
            } else {
                const float rs = RS[wave];
                const float hiT = (Bb >= 511) ? INFINITY : (float)(Bb + 1), loT = (Bb <= 0) ? -INFINITY : (float)Bb;
                const int jt = t >> 6; const unsigned long long tailm = (~0ull) >> (63 - (t & 63));
                unsigned long long w0 = 0ull, w1 = 0ull;
                int cnt = 0;
#define SEL_CHUNK(fv, j, vm) do { \
                        const float vv = __builtin_fmaf((fv), rs, 256.0f); \
                        const unsigned long long mh = __ballot(vv >= hiT) & (vm); \
                        const unsigned long long mc = __ballot(vv >= loT) & (vm) & ~mh; \
                        if (lane == ((j) & 63)) { if ((j) < 64) w0 = mh; else w1 = mh; } \
                        if (mc != 0ull) { \
                            const bool is = (mc >> lane) & 1ull; \
                            const int pos = cnt + (int)__builtin_amdgcn_mbcnt_hi((unsigned)(mc >> 32), __builtin_amdgcn_mbcnt_lo((unsigned)mc, 0u)); \
                            if (is && pos < 64) { CAND[wave * 64 + pos] = ord_key(fv); CIDX[wave * 64 + pos] = (unsigned)(64 * (j) + lane); } \
                            cnt += __popcll(mc); \
                        } } while (0)
                int j0 = 0;
                for (; j0 + 4 <= jt; j0 += 4) {
                    float f4[4];
#pragma unroll
                    for (int i = 0; i < 4; ++i) f4[i] = Sr[64 * (j0 + i) + lane];
#pragma unroll
                    for (int i = 0; i < 4; ++i) SEL_CHUNK(f4[i], j0 + i, ~0ull);
                }
                for (; j0 <= jt; ++j0) {
                    const float f1 = Sr[64 * j0 + lane];
                    const unsigned long long vm = (j0 < jt) ? ~0ull : tailm;
                    SEL_CHUNK(f1, j0, vm);
                }
#undef SEL_CHUNK
                asm volatile("s_waitcnt lgkmcnt(0)" ::: "memory");
                const unsigned myk = (lane < cB) ? CAND[wave * 64 + lane] : 0u;
                const unsigned myi = (lane < cB) ? CIDX[wave * 64 + lane] : 0u;
                int rank = 0;
                for (int jj = 0; jj < cB; ++jj) { const unsigned kj = (unsigned)__builtin_amdgcn_readlane((int)myk, jj); rank += ((kj > myk) || (kj == myk && jj < lane)) ? 1 : 0; }
                unsigned long long chosen = __ballot(lane < cB && rank < rr);
                while (chosen != 0ull) {
                    const int c = (int)__ffsll((unsigned long long)chosen) - 1; chosen &= chosen - 1ull;
                    const unsigned ci = (unsigned)__builtin_amdgcn_readlane((int)myi, c);
                    const int jc = (int)(ci >> 6); const unsigned long long bit = 1ull << (ci & 63u);
                    if (lane == (jc & 63)) { if (jc < 64) w0 |= bit; else w1 |= bit; }
                }
                if (lane < nj) brow[lane] = w0;
                if (lane < 2 && 64 + lane < nj) brow[64 + lane] = w1;
            }
        }
    }
    __syncthreads();
}

__device__ __forceinline__ void conv_tile(int b, int ti, const bf16_t* U, const bf16_t* ZC, const float* cw, const float* cb, const float* lg, const float* lb,
                                          bf16_t* YMIX, LAS float* C, int tid, int wave, int lane) {
    const int t0 = 32 * ti;
    {
        const int cp = tid & 255, rh = tid >> 8;
        float w0[31], w1[31];
#pragma unroll
        for (int j = 0; j < 31; ++j) { const f32x2 ww = *(const f32x2*)(cw + j * 512 + 2 * cp); w0[j] = ww[0]; w1[j] = ww[1]; }
        const f32x2 bias = *(const f32x2*)(cb + 2 * cp);
        float x0[46], x1[46];
#pragma unroll
        for (int i = 0; i < 46; ++i) { const int t = t0 - 30 + 16 * rh + i; x0[i] = 0.f; x1[i] = 0.f;
            if (t >= 0) { const unsigned pu = *(const unsigned*)(U + (size_t)(b * LP + t) * 512 + 2 * cp); x0[i] = bflo(pu); x1[i] = bfhi(pu); } }
#pragma unroll
        for (int o = 0; o < 16; ++o) { float a0 = bias[0], a1 = bias[1];
#pragma unroll
            for (int j = 0; j < 31; ++j) { a0 = fmaf(w0[j], x0[o + j], a0); a1 = fmaf(w1[j], x1[o + j], a1); }
            f32x2 r2; r2[0] = a0; r2[1] = a1; *(LAS f32x2*)(C + (16 * rh + o) * 512 + 2 * cp) = r2; }
    }
    const f32x4 g0 = *(const f32x4*)(lg + lane * 8), g1 = *(const f32x4*)(lg + lane * 8 + 4), b0 = *(const f32x4*)(lb + lane * 8), b1 = *(const f32x4*)(lb + lane * 8 + 4);
    u32x4 zz[4];
#pragma unroll
    for (int rr = 0; rr < 4; ++rr) zz[rr] = *(const u32x4*)(ZC + (size_t)(b * LP + t0 + 4 * wave + rr) * 512 + lane * 8);
    asm volatile("s_waitcnt lgkmcnt(0)\n\ts_barrier" ::: "memory");
    {
        f32x4 a0[4], a1[4]; float sm[4], sq[4];
#pragma unroll
        for (int rr = 0; rr < 4; ++rr) { const LAS float* cr = C + (4 * wave + rr) * 512 + lane * 8; a0[rr] = *(const LAS f32x4*)cr; a1[rr] = *(const LAS f32x4*)(cr + 4);
            sm[rr] = (a0[rr][0] + a0[rr][1]) + (a0[rr][2] + a0[rr][3]) + (a1[rr][0] + a1[rr][1]) + (a1[rr][2] + a1[rr][3]); }
#pragma unroll
        for (int o = 1; o < 64; o <<= 1) {
#pragma unroll
            for (int rr = 0; rr < 4; ++rr) sm[rr] += __shfl_xor(sm[rr], o); }
#pragma unroll
        for (int rr = 0; rr < 4; ++rr) { const float mean = sm[rr] * (1.f / 512.f); a0[rr] = a0[rr] - mean; a1[rr] = a1[rr] - mean;
            sq[rr] = (a0[rr][0] * a0[rr][0] + a0[rr][1] * a0[rr][1]) + (a0[rr][2] * a0[rr][2] + a0[rr][3] * a0[rr][3]) + (a1[rr][0] * a1[rr][0] + a1[rr][1] * a1[rr][1]) + (a1[rr][2] * a1[rr][2] + a1[rr][3] * a1[rr][3]); }
#pragma unroll
        for (int o = 1; o < 64; o <<= 1) {
#pragma unroll
            for (int rr = 0; rr < 4; ++rr) sq[rr] += __shfl_xor(sq[rr], o); }
#pragma unroll
        for (int rr = 0; rr < 4; ++rr) {
            const float rstd = 1.0f / sqrtf(sq[rr] * (1.f / 512.f) + LN_EPS);
            const size_t row = (size_t)(b * LP + t0 + 4 * wave + rr);
            const u32x4 z = zz[rr];
            const f32x4 y0 = a0[rr] * rstd * g0 + b0, y1 = a1[rr] * rstd * g1 + b1;
            u32x4 w;
            w.x = pk2(y0[0] * sigmoidf_(y0[0]) * bflo(z.x), y0[1] * sigmoidf_(y0[1]) * bfhi(z.x));
            w.y = pk2(y0[2] * sigmoidf_(y0[2]) * bflo(z.y), y0[3] * sigmoidf_(y0[3]) * bfhi(z.y));
            w.z = pk2(y1[0] * sigmoidf_(y1[0]) * bflo(z.z), y1[1] * sigmoidf_(y1[1]) * bfhi(z.z));
            w.w = pk2(y1[2] * sigmoidf_(y1[2]) * bflo(z.w), y1[3] * sigmoidf_(y1[3]) * bfhi(z.w));
            *(u32x4*)(YMIX + row * 1024 + lane * 8) = w;
        }
    }
    asm volatile("s_waitcnt lgkmcnt(0)\n\ts_barrier" ::: "memory");
}

constexpr int KSTR = 272, VSTR = 320;
typedef short v4i16_t __attribute__((ext_vector_type(4)));
__device__ __forceinline__ float vmax3(float a, float b, float c) { float r; asm("v_max3_f32 %0, %1, %2, %3" : "=v"(r) : "v"(a), "v"(b), "v"(c)); return r; }
#define bfe1(w, c) ({ unsigned m_; asm("v_bfe_i32 %0, %1, %2, 1" : "=v"(m_) : "v"(w), "n"(c)); m_; })
__device__ __forceinline__ void attn_unit(int b, int hp, int qb, const bf16_t* Q, const bf16_t* K, const bf16_t* V, const bf16_t* ZA, const unsigned* BITS, bf16_t* YMIX,
                                          LAS unsigned char* lds, int tid, int wave, int lane) {
    const int hl = wave >> 2, h = 2 * hp + hl;
    const int q0 = 128 * qb, qw0 = q0 + 32 * (wave & 3);
    const int n = lane & 31, hh = lane >> 5;
    const size_t qrow = (size_t)(b * LP + qw0 + n);
    bf16x8 qf[4];
#pragma unroll
    for (int ks = 0; ks < 4; ++ks) qf[ks] = *(const bf16x8*)(Q + qrow * 512 + h * 64 + ks * 16 + hh * 8);
    const int NT = 2 * qb + 2;
    LAS unsigned char* Ks = lds; LAS unsigned char* Vs = lds + 2 * 64 * KSTR;
    const int r0 = tid >> 4, ch = tid & 15;
    const size_t gb = (size_t)(b * LP) * 512 + hp * 128 + ch * 8;
    u32x4 kA0, kA1, vA0, vA1, kB0, kB1, vB0, vB1;
#define ATT_LOAD(tile, k0, k1, v0, v1) do { const size_t ro = gb + (size_t)(64 * (tile) + r0) * 512; k0 = *(const u32x4*)(K + ro); k1 = *(const u32x4*)(K + ro + 32 * 512); v0 = *(const u32x4*)(V + ro); v1 = *(const u32x4*)(V + ro + 32 * 512); } while (0)
#define ATT_STORE(buf, k0, k1, v0, v1) do { *(LAS u32x4*)(Ks + (buf) * 64 * KSTR + r0 * KSTR + ch * 16) = k0; *(LAS u32x4*)(Ks + (buf) * 64 * KSTR + (r0 + 32) * KSTR + ch * 16) = k1; \
        *(LAS u32x4*)(Vs + (buf) * 64 * VSTR + r0 * VSTR + ch * 16) = v0; *(LAS u32x4*)(Vs + (buf) * 64 * VSTR + (r0 + 32) * VSTR + ch * 16) = v1; } while (0)
#define ATT_BAR() asm volatile("s_waitcnt lgkmcnt(0)\n\ts_barrier" ::: "memory")
    const unsigned long long* mrow = (const unsigned long long*)(BITS + qrow * BW);
    ATT_LOAD(0, kA0, kA1, vA0, vA1); ATT_LOAD(1, kB0, kB1, vB0, vB1);
    ATT_STORE(0, kA0, kA1, vA0, vA1);
    if (NT > 2) ATT_LOAD(2, kA0, kA1, vA0, vA1);
    unsigned long long mwA = mrow[0], mwB = mrow[1];
    ATT_BAR();
    float mrun = 0.f, lrun = 0.f; f32x16 o0 = {}, o1 = {}, negm = {};
    const int qq4 = (lane & 15) >> 2, pp = lane & 3, blk = (lane >> 4) & 1;
    for (int tile2 = 0; tile2 < NT; tile2 += 2) {
#pragma unroll
        for (int half = 0; half < 2; ++half) {
            const int tile = tile2 + half; const int buf = half;
            const unsigned long long mw = half ? mwB : mwA;
            if (64 * tile <= qw0 + 31 && qw0 < LV) {
            f32x16 s0 = negm, s1 = negm;
            const LAS unsigned char* kb = Ks + buf * 64 * KSTR + n * KSTR + hl * 128 + hh * 16;
            bf16x8 kf0[4], kf1[4];
#pragma unroll
            for (int ks = 0; ks < 4; ++ks) { kf0[ks] = *(const LAS bf16x8*)(kb + ks * 32); kf1[ks] = *(const LAS bf16x8*)(kb + 32 * KSTR + ks * 32); }
            __builtin_amdgcn_sched_barrier(0);
#pragma unroll
            for (int ks = 0; ks < 4; ++ks) {
                s0 = __builtin_amdgcn_mfma_f32_32x32x16_bf16(kf0[ks], qf[ks], s0, 0, 0, 0);
                s1 = __builtin_amdgcn_mfma_f32_32x32x16_bf16(kf1[ks], qf[ks], s1, 0, 0, 0);
            }
            const LAS unsigned char* vb = Vs + buf * 64 * VSTR + (4 * hh + qq4) * VSTR + (hl * 64 + 16 * blk + 4 * pp) * 2;
            s16x4 vlo[2][2][2], vhi[2][2][2];
#pragma unroll
            for (int mb = 0; mb < 2; ++mb)
#pragma unroll
                for (int ks = 0; ks < 2; ++ks)
#pragma unroll
                    for (int db = 0; db < 2; ++db) {
                        const LAS unsigned char* vk = vb + (32 * mb + 16 * ks) * VSTR;
                        vlo[mb][ks][db] = __builtin_bit_cast(s16x4, __builtin_amdgcn_ds_read_tr16_b64_v4i16((LAS v4i16_t*)(vk + db * 64)));
                        vhi[mb][ks][db] = __builtin_bit_cast(s16x4, __builtin_amdgcn_ds_read_tr16_b64_v4i16((LAS v4i16_t*)(vk + 8 * VSTR + db * 64)));
                    }
            __builtin_amdgcn_sched_barrier(0);
            float mxa = fmaxf(s0[0], s1[0]), mxb = fmaxf(s0[1], s1[1]);
#pragma unroll
            for (int r = 2; r < 16; r += 2) { mxa = vmax3(mxa, s0[r], s1[r]); mxb = vmax3(mxb, s0[r + 1], s1[r + 1]); }
            float mx = fmaxf(mxa, mxb);
            if (__any(mx > 6.0f)) {
                mx = fmaxf(mx, __shfl_xor(mx, 32));
                const float dl = fmaxf(mx, 0.f);
                mrun += dl;
                const float alpha = __builtin_amdgcn_exp2f(-dl);
                lrun *= alpha;
#pragma unroll
                for (int r = 0; r < 16; ++r) { s0[r] -= dl; s1[r] -= dl; o0[r] *= alpha; o1[r] *= alpha; negm[r] = -mrun; }
            }
            const int wl = (int)((unsigned)mw >> (4 * hh)), wh = (int)((unsigned)(mw >> 32) >> (4 * hh));
            f32x2 ps2 = {0.f, 0.f};
#pragma unroll
            for (int r = 0; r < 16; r += 2) {
                const int c0b = (r & 3) + 8 * (r >> 2), c1b = ((r + 1) & 3) + 8 * ((r + 1) >> 2);
                const float a0 = __uint_as_float(__float_as_uint(__builtin_amdgcn_exp2f(s0[r])) & bfe1(wl, c0b));
                const float a1 = __uint_as_float(__float_as_uint(__builtin_amdgcn_exp2f(s0[r + 1])) & bfe1(wl, c1b));
                const float b0 = __uint_as_float(__float_as_uint(__builtin_amdgcn_exp2f(s1[r])) & bfe1(wh, c0b));
                const float b1 = __uint_as_float(__float_as_uint(__builtin_amdgcn_exp2f(s1[r + 1])) & bfe1(wh, c1b));
                s0[r] = a0; s0[r + 1] = a1; s1[r] = b0; s1[r + 1] = b1;
                ps2 += (f32x2){a0, a1}; ps2 += (f32x2){b0, b1};
            }
            lrun += ps2[0] + ps2[1];
            __builtin_amdgcn_sched_barrier(0);
#pragma unroll
            for (int mb = 0; mb < 2; ++mb)
#pragma unroll
                for (int ks = 0; ks < 2; ++ks) {
                    bf16x8 pf;
                    { u32x4 pw;
                      if (mb == 0) { pw.x = pk2(s0[8 * ks + 0], s0[8 * ks + 1]); pw.y = pk2(s0[8 * ks + 2], s0[8 * ks + 3]); pw.z = pk2(s0[8 * ks + 4], s0[8 * ks + 5]); pw.w = pk2(s0[8 * ks + 6], s0[8 * ks + 7]); }
                      else         { pw.x = pk2(s1[8 * ks + 0], s1[8 * ks + 1]); pw.y = pk2(s1[8 * ks + 2], s1[8 * ks + 3]); pw.z = pk2(s1[8 * ks + 4], s1[8 * ks + 5]); pw.w = pk2(s1[8 * ks + 6], s1[8 * ks + 7]); }
                      pf = __builtin_bit_cast(bf16x8, pw); }
#pragma unroll
                    for (int db = 0; db < 2; ++db) {
                        const s16x4 lo = vlo[mb][ks][db], hi = vhi[mb][ks][db];
                        const bf16x8 vf = (bf16x8){lo[0], lo[1], lo[2], lo[3], hi[0], hi[1], hi[2], hi[3]};
                        if (db == 0) o0 = __builtin_amdgcn_mfma_f32_32x32x16_bf16(vf, pf, o0, 0, 0, 0);
                        else         o1 = __builtin_amdgcn_mfma_f32_32x32x16_bf16(vf, pf, o1, 0, 0, 0);
                    }
                }
            }
            if (half == 0) {
                ATT_STORE(1, kB0, kB1, vB0, vB1);
                if (tile + 3 < NT) ATT_LOAD(tile + 3, kB0, kB1, vB0, vB1);
                if (tile + 2 < NT) mwA = mrow[tile + 2];
            } else {
                if (tile + 1 < NT) { ATT_STORE(0, kA0, kA1, vA0, vA1); if (tile + 3 < NT) ATT_LOAD(tile + 3, kA0, kA1, vA0, vA1); }
                if (tile + 2 < NT) mwB = mrow[tile + 2];
            }
            ATT_BAR();
        }
    }
#undef ATT_LOAD
#undef ATT_STORE
#undef ATT_BAR
    lrun += __shfl_xor(lrun, 32);
    const float inv = 1.0f / lrun;
#pragma unroll
    for (int db = 0; db < 2; ++db)
#pragma unroll
        for (int g4 = 0; g4 < 4; ++g4) {
            const int d0 = 32 * db + 8 * g4 + 4 * hh;
            const u32x2 z = *(const u32x2*)(ZA + qrow * 512 + h * 64 + d0);
            float v0, v1, v2, v3;
            if (db == 0) { v0 = o0[4 * g4]; v1 = o0[4 * g4 + 1]; v2 = o0[4 * g4 + 2]; v3 = o0[4 * g4 + 3]; } else { v0 = o1[4 * g4]; v1 = o1[4 * g4 + 1]; v2 = o1[4 * g4 + 2]; v3 = o1[4 * g4 + 3]; }
            u32x2 w; w.x = pk2(v0 * inv * bflo(z.x), v1 * inv * bfhi(z.x)); w.y = pk2(v2 * inv * bflo(z.y), v3 * inv * bfhi(z.y));
            *(u32x2*)(YMIX + qrow * 1024 + 512 + h * 64 + d0) = w;
        }
}

__device__ __forceinline__ void ln_phase(const Params& p, int l, int wave, int lane) {
    const int gw = blockIdx.x * 8 + wave, NGW = gridDim.x * 8;
    bf16_t* HB = (bf16_t*)(p.ws + WS_HB); float* METAH = (float*)(p.ws + WS_METAH);
    const float* G = p.post_g + l * 1024; const float* Bv = p.post_b + l * 1024;
    f32x4 gg[4], bb[4];
#pragma unroll
    for (int j = 0; j < 4; ++j) { gg[j] = *((const f32x4*)G + lane + 64 * j); bb[j] = *((const f32x4*)Bv + lane + 64 * j); }
    constexpr int NGRP = NB * LV / 4;
    for (int g = gw; g < NGRP; g += NGW) {
        const int v0 = 4 * g; const int b = v0 / LV, t0 = v0 - b * LV;
        float* hp[4]; f32x4 v[4][4]; float s[4], q[4];
#pragma unroll
        for (int i = 0; i < 4; ++i) { const int t = t0 + i; hp[i] = (t < NMETA) ? (METAH + (size_t)(b * NMETA + t) * 1024) : (p.out + ((size_t)b * SEQ + (t - NMETA)) * 1024); }
#pragma unroll
        for (int i = 0; i < 4; ++i) { s[i] = 0.f;
#pragma unroll
            for (int j = 0; j < 4; ++j) { v[i][j] = *((const f32x4*)hp[i] + lane + 64 * j); } }
#pragma unroll
        for (int i = 0; i < 4; ++i)
#pragma unroll
            for (int j = 0; j < 4; ++j) s[i] += (v[i][j][0] + v[i][j][1]) + (v[i][j][2] + v[i][j][3]);
#pragma unroll
        for (int o = 1; o < 64; o <<= 1) {
#pragma unroll
            for (int i = 0; i < 4; ++i) s[i] += __shfl_xor(s[i], o); }
#pragma unroll
        for (int i = 0; i < 4; ++i) { const float mean = s[i] * (1.f / 1024.f); s[i] = mean; q[i] = 0.f;
#pragma unroll
            for (int j = 0; j < 4; ++j) { v[i][j] = v[i][j] - mean; q[i] += (v[i][j][0] * v[i][j][0] + v[i][j][1] * v[i][j][1]) + (v[i][j][2] * v[i][j][2] + v[i][j][3] * v[i][j][3]); } }
#pragma unroll
        for (int o = 1; o < 64; o <<= 1) {
#pragma unroll
            for (int i = 0; i < 4; ++i) q[i] += __shfl_xor(q[i], o); }
#pragma unroll
        for (int i = 0; i < 4; ++i) {
            const float rstd = 1.0f / sqrtf(q[i] * (1.f / 1024.f) + LN_EPS);
            const size_t r = (size_t)(b * LP + t0 + i);
            u32x2* o = (u32x2*)(HB + r * 1024) + lane;
            if (lane == 0 && l < DEPTH - 1) { f32x2 st; st[0] = s[i]; st[1] = rstd; *(f32x2*)((float*)(p.ws + WS_STAT) + r * 2) = st; }
#pragma unroll
            for (int j = 0; j < 4; ++j) { const f32x4 y = v[i][j] * rstd * gg[j] + bb[j]; if (l == DEPTH - 1) *((f32x4*)hp[i] + lane + 64 * j) = y;
                if (l < DEPTH - 1) { u32x2 w; w.x = pk2(y[0], y[1]); w.y = pk2(y[2], y[3]); o[64 * j] = w; } }
        }
    }
}

#define XB_TMO      128
#define XB_XCNT(j)  (256  + 64 * (j))
#define XB_XSUB(j)  (1280 + 64 * (j))
#define XB_XGEN(j)  (2304 + 64 * (j))
#define XB_TOP      3328
#define XB_TOPGEN   3392
#define XCD_BAR_WORDS 3456
#define XB_SPIN_CAP (1u << 18)

__device__ __forceinline__ unsigned xb_ld(unsigned* p)              { return __hip_atomic_load(p, __ATOMIC_RELAXED, __HIP_MEMORY_SCOPE_AGENT); }
__device__ __forceinline__ unsigned xb_add(unsigned* p, unsigned v) { return __hip_atomic_fetch_add(p, v, __ATOMIC_RELAXED, __HIP_MEMORY_SCOPE_AGENT); }
__device__ __forceinline__ unsigned xb_xcc_id() { return (unsigned)__builtin_amdgcn_s_getreg((3 << 11) | 20) & 0xFu; }
#define XB_SPIN(cond, bar) do { unsigned _sp = 0; while (cond) { __builtin_amdgcn_s_sleep(1); \
    if ((++_sp & 255u) == 0u) { if (xb_ld(&(bar)[XB_TMO])) break; if (_sp > XB_SPIN_CAP) { atomicAdd(&(bar)[XB_TMO], 1u); break; } } } } while (0)

struct XcdBarrier {
    unsigned* bar; unsigned x;
    volatile LAS unsigned* st;
};

__device__ __forceinline__ XcdBarrier xcd_barrier_post(unsigned* bar, volatile LAS unsigned* st) {
    XcdBarrier b; b.bar = bar; b.x = xb_xcc_id(); b.st = st;
    if (threadIdx.x == 0) (void)xb_add(&bar[XB_XCNT(b.x)], 1u);
    return b;
}
__device__ __forceinline__ void xcd_barrier_complete(unsigned* bar, unsigned x, unsigned& nloc, unsigned& nx) {
    const unsigned G = gridDim.x * gridDim.y * gridDim.z;
    unsigned sum, cnt, mine, sp = 0u;
    for (;;) {
        sum = 0u; cnt = 0u; mine = 0u;
#pragma unroll
        for (unsigned j = 0; j < 16; ++j) { const unsigned c = xb_ld(&bar[XB_XCNT(j)]); sum += c; cnt += (c > 0u) ? 1u : 0u; mine = (j == x) ? c : mine; }
        if (sum == G) break;
        __builtin_amdgcn_s_sleep(1);
        if ((++sp & 255u) == 0u) { if (xb_ld(&bar[XB_TMO])) break; if (sp > XB_SPIN_CAP) { atomicAdd(&bar[XB_TMO], 1u); break; } }
    }
    nloc = mine > 0u ? mine : 1u; nx = cnt > 0u ? cnt : 1u;
}

__device__ __forceinline__ void xcd_barrier(const XcdBarrier& b) {
    asm volatile("s_waitcnt vmcnt(0)" ::: "memory");
    __syncthreads();
    if (threadIdx.x == 0) {
        unsigned* bar = b.bar;
        __builtin_amdgcn_s_waitcnt(0);
        unsigned nloc = b.st[0], nx = b.st[1];
        if (nloc == 0u) { xcd_barrier_complete(bar, b.x, nloc, nx); b.st[0] = nloc; b.st[1] = nx; }
        const unsigned old = xb_add(&bar[XB_XSUB(b.x)], 1u);
        const unsigned gen = old / nloc;
        if (old + 1u == (gen + 1u) * nloc) {
            __builtin_amdgcn_fence(__ATOMIC_RELEASE, "agent");
            asm volatile("s_waitcnt vmcnt(0)" ::: "memory");
            const unsigned og = xb_add(&bar[XB_TOP], 1u);
            const unsigned tg = og / nx;
            if (og + 1u == (tg + 1u) * nx) xb_add(&bar[XB_TOPGEN], 1u);
            else XB_SPIN(xb_ld(&bar[XB_TOPGEN]) == tg, bar);
            __builtin_amdgcn_fence(__ATOMIC_ACQUIRE, "agent");
            xb_add(&bar[XB_XGEN(b.x)], 1u);
            asm volatile("s_waitcnt vmcnt(0)" ::: "memory");
        } else {
            XB_SPIN(xb_ld(&bar[XB_XGEN(b.x)]) == gen, bar);
            __builtin_amdgcn_fence(__ATOMIC_ACQUIRE, "agent");
            asm volatile("s_waitcnt vmcnt(0)" ::: "memory");
        }
    }
    __syncthreads();
}

#ifndef REP_P2
#define REP_P2 1
#endif
#ifndef REP_IDX
#define REP_IDX 1
#endif
#ifndef REP_CONV
#define REP_CONV 1
#endif
#ifndef REP_P0
#define REP_P0 1
#endif
#ifndef REP_SYNC
#define REP_SYNC 0
#endif
#ifndef REP_P3
#define REP_P3 1
#endif
#ifndef REP_G1
#define REP_G1 1
#endif
__global__ void __launch_bounds__(512, 2) fwd_megakernel(Params p) {
    extern __shared__ __attribute__((aligned(16))) unsigned char lds_raw[];
    cg::grid_group grid = cg::this_grid();
    LAS unsigned char* lds = (LAS unsigned char*)lds_raw;
    const int tid = threadIdx.x, lane = tid & 63, wave = __builtin_amdgcn_readfirstlane(tid >> 6);
    const int G = gridDim.x, bx = blockIdx.x;
    unsigned char* ws = p.ws;
    bf16_t* HB = (bf16_t*)(ws + WS_HB);
    bf16_t *U = (bf16_t*)(ws + WS_U), *ZC = (bf16_t*)(ws + WS_ZC), *Q = (bf16_t*)(ws + WS_Q), *K = (bf16_t*)(ws + WS_K), *V = (bf16_t*)(ws + WS_V),
           *ZA = (bf16_t*)(ws + WS_ZA), *QI = (bf16_t*)(ws + WS_QI), *KI = (bf16_t*)(ws + WS_KI), *YMIX = (bf16_t*)(ws + WS_YMIX);
    float* WI = (float*)(ws + WS_WI); unsigned* BITS = (unsigned*)(ws + WS_BITS); float* METAH = (float*)(ws + WS_METAH);
    const float* cosT = (const float*)(ws + WS_COS); const float* sinT = (const float*)(ws + WS_SIN);

    if (tid < 16) ((LAS unsigned*)(lds + LDS_BYTES - 64))[tid] = 0u;
    __syncthreads();
    const XcdBarrier xbar = xcd_barrier_post((unsigned*)(ws + WS_BAR), (volatile LAS unsigned*)(lds + LDS_BYTES - 64));
#define GSYNC() xcd_barrier(xbar)
    if (p.ws == nullptr) grid.sync();
#ifndef NO_P0
    for (int rp_ = 0; rp_ < REP_P0; ++rp_) p0_prologue(p, lds, wave, lane);
#endif
    GSYNC();
    for (int rs_ = 0; rs_ < REP_SYNC; ++rs_) GSYNC();

#define LAUNDER() int tid_ = tid, wave_ = wave; asm volatile("" : "+v"(tid_)); asm volatile("" : "+s"(wave_)); const int lane_ = tid_ & 63; (void)lane_; (void)wave_
#pragma unroll 1
    for (int l = 0; l < DEPTH; ++l) {
#ifndef NO_G1
        for (int rep_ = 0; rep_ < REP_G1; ++rep_) {
            pg8::Gemm g{HB, (const bf16_t*)(ws + WS_WIN) + (size_t)l * NPAD * 1024, NR, NPAD, 1024};
            pg8::StaticOrder S; S.init(NR, NPAD, G, bx);
            EpiIn E{U, ZC, Q, K, V, ZA, QI, KI, WI, cosT, sinT};
            pg8::gemm_phase<EpiIn, pg8::StaticOrder, true, true>(lds, g, S, E);
        }
#endif
        GSYNC();
#ifndef NO_P2
        for (int rep_ = 0; rep_ < REP_P2; ++rep_) {
            LAUNDER();
            constexpr int NITEM = NB * (LV / 8);
            for (int ri_ = 0; ri_ < REP_IDX; ++ri_)
            for (int k = 0; k * G < NITEM; ++k) {
                const int idx = (k & 1) ? (k * G + (G - 1 - bx)) : (k * G + bx);
                if (idx < NITEM) { const int g = (LV / 8 - 1) - idx / NB, b = idx % NB; idx_item(b, g, QI, KI, WI, BITS, lds, tid_, wave_, lane_); }
            }
            constexpr int NCT = NB * (LP / 32);
            for (int rc_ = 0; rc_ < REP_CONV; ++rc_)
            for (int ct = (G - 1 - bx); ct < NCT; ct += G) {
                const int b = ct / (LP / 32), ti = ct - b * (LP / 32);
                if (32 * ti >= LV) continue;
                conv_tile(b, ti, U, ZC, p.conv_w + (size_t)l * 31 * 512, p.conv_b + l * 512, p.conv_ln_g + l * 512, p.conv_ln_b + l * 512, YMIX, (LAS float*)lds, tid_, wave_, lane_);
            }
        }
#endif
        GSYNC();
#ifndef NO_P3
        for (int rep_ = 0; rep_ < REP_P3; ++rep_) {
            LAUNDER();
            constexpr int NU = NB * 4 * (LP / 128);
            for (int k = 0; k * G < NU; ++k) {
                const int idx = (k & 1) ? (k * G + (G - 1 - bx)) : (k * G + bx);
                if (idx < NU) { const int qb = (LP / 128 - 1) - idx / 32, bh = idx % 32; attn_unit(bh >> 2, bh & 3, qb, Q, K, V, ZA, BITS, YMIX, lds, tid_, wave_, lane_); }
            }
        }
#endif
        GSYNC();
#ifndef NO_G2
        {
            pg8::Gemm g{YMIX, (const bf16_t*)(ws + WS_WOUT) + (size_t)l * 1024 * 1024, NR, 1024, 1024};
            pg8::StaticOrder S; S.init(NR, 1024, G, bx);
            EpiOut E{l == 0 ? p.x : p.out, l == 0 ? p.meta : METAH, l == 0 ? 0 : NMETA * 1024, p.out, METAH,
                     l == 0 ? (const float*)nullptr : (const float*)(ws + WS_STAT), p.post_g + (l > 0 ? l - 1 : 0) * 1024, p.post_b + (l > 0 ? l - 1 : 0) * 1024, (float*)(ws + WS_DUMP)};
            pg8::gemm_phase<EpiOut, pg8::StaticOrder, true, true>(lds, g, S, E);
            if (l + 1 < DEPTH && G > 16 && bx >= 16) { LAUNDER(); convert_layer(p, l + 1, lds, (bx - 16) * 8 + wave_, (G - 16) * 8, wave_, lane_); }
            else if (l + 1 < DEPTH && G <= 16) { LAUNDER(); convert_layer(p, l + 1, lds, bx * 8 + wave_, G * 8, wave_, lane_); }
        }
#endif
        GSYNC();
#ifndef NO_P4
        { LAUNDER(); ln_phase(p, l, wave_, lane_); }
#endif
        if (l < DEPTH - 1) GSYNC();
    }
}

extern "C" void kernel_launch(void* const* d_in, const int* in_sizes, int n_in, void* d_out, int out_size, void* d_ws, size_t ws_size, hipStream_t stream) {
    static int grid_blocks = 0;
    if (grid_blocks == 0) {
        if (ws_size < WS_END) { fprintf(stderr, "kernel_launch: workspace too small: %zu < %zu\n", ws_size, (size_t)WS_END); grid_blocks = -1; return; }
        int dev = 0, cus = 0, per_cu = 0;
        hipGetDevice(&dev);
        hipDeviceGetAttribute(&cus, hipDeviceAttributeMultiprocessorCount, dev);
        if (hipFuncSetAttribute((const void*)fwd_megakernel, hipFuncAttributeMaxDynamicSharedMemorySize, LDS_BYTES) != hipSuccess) { fprintf(stderr, "kernel_launch: hipFuncSetAttribute failed\n"); }
        if (hipOccupancyMaxActiveBlocksPerMultiprocessor(&per_cu, (const void*)fwd_megakernel, 512, LDS_BYTES) != hipSuccess || per_cu < 1) { fprintf(stderr, "kernel_launch: occupancy query gave %d\n", per_cu); per_cu = 1; }
        (void)hipGetLastError();
        if (per_cu > 1) per_cu = 1;
        grid_blocks = cus * per_cu;
    }
    if (grid_blocks < 0) return;
    Params p{};
    p.x = (const float*)d_in[0]; p.meta = (const float*)d_in[1]; p.w_in = (const float*)d_in[2]; p.conv_w = (const float*)d_in[3]; p.conv_b = (const float*)d_in[4];
    p.conv_ln_g = (const float*)d_in[5]; p.conv_ln_b = (const float*)d_in[6]; p.w_out = (const float*)d_in[7]; p.post_g = (const float*)d_in[8]; p.post_b = (const float*)d_in[9];
    p.out = (float*)d_out; p.ws = (unsigned char*)d_ws;
    void* args[] = {&p};
    if (hipMemsetAsync((char*)d_ws + WS_BAR, 0, 16384, stream) != hipSuccess) { fprintf(stderr, "kernel_launch: hipMemsetAsync of the barrier words failed\n"); return; }
    hipError_t e = hipLaunchCooperativeKernel((const void*)fwd_megakernel, dim3(grid_blocks), dim3(512), args, LDS_BYTES, stream);
    if (e != hipSuccess) fprintf(stderr, "cooperative launch failed: %s (grid %d)\n", hipGetErrorString(e), grid_blocks);
}
```
